# Optimizing an MI355X kernel written in HIP

```python
import jax, jax.numpy as jnp
from jax import lax
import numpy as np

D_MODEL = 1024
BATCH = 8
SEQ = 2048
DEPTH = 1
DEC_BATCH = 2
DEC_SEQ = 8192
PAST_LEN = 128

N_META = 16
BLOCK = 128
WINDOW = 128
LEAD_PAD = BLOCK - N_META
ROPE_THETA = 10000.0
EPS = 1e-6
NEG = -1e30
MLA_HEADS = 8
MLA_Q_LORA = 384
MLA_KV_LORA = 256
MLA_NOPE = 64
MLA_ROPE = 32
MLA_V = 64
SWA_HEADS = 8
SWA_KV_HEADS = 2
SWA_HEAD_DIM = 64
SWA_GROUP = SWA_HEADS // SWA_KV_HEADS
D_FF = 2816
COL_SIZES = (MLA_Q_LORA, MLA_KV_LORA, MLA_ROPE,
             SWA_HEADS * SWA_HEAD_DIM, SWA_KV_HEADS * SWA_HEAD_DIM, SWA_KV_HEADS * SWA_HEAD_DIM,
             D_MODEL, D_MODEL)
D_IN = sum(COL_SIZES)

kernel_name = "hybrid_mla_window_gqa_macaron_encoder"


def rms_norm(x, g):
    xf = x.astype(jnp.float32)
    y = xf * lax.rsqrt(jnp.mean(xf * xf, axis=-1, keepdims=True) + EPS)
    return (y * g.astype(jnp.float32)).astype(x.dtype)


def rope(x, pos):
    half = x.shape[-1] // 2
    inv = ROPE_THETA ** (-jnp.arange(half, dtype=jnp.float32) / half)
    ang = pos.astype(jnp.float32)[:, None] * inv[None, :]
    cos = jnp.cos(ang)[:, None, :]
    sin = jnp.sin(ang)[:, None, :]
    xf = x.astype(jnp.float32)
    x1, x2 = xf[..., :half], xf[..., half:]
    return jnp.concatenate([x1 * cos - x2 * sin, x2 * cos + x1 * sin], axis=-1).astype(x.dtype)


def swiglu(x, w_in, w_out):
    a = x @ w_in
    g, u = a[..., :D_FF], a[..., D_FF:]
    return (jax.nn.silu(g) * u) @ w_out


def mla(c_q, c_kv, k_rope, pos, key_ok, q_norm_g, w_uq, kv_norm_g, w_ukv):
    B, L, _ = c_q.shape
    q = (rms_norm(c_q, q_norm_g) @ w_uq).reshape(B, L, MLA_HEADS, MLA_NOPE + MLA_ROPE)
    q_nope = q[..., :MLA_NOPE]
    q_rope = rope(q[..., MLA_NOPE:], pos)
    kv = (rms_norm(c_kv, kv_norm_g) @ w_ukv).reshape(B, L, MLA_HEADS, MLA_NOPE + MLA_V)
    k_nope = kv[..., :MLA_NOPE]
    v = kv[..., MLA_NOPE:]
    k_r = rope(k_rope[:, :, None, :], pos)[:, :, 0, :]
    scale = (MLA_NOPE + MLA_ROPE) ** -0.5
    bias = jnp.where(key_ok, 0.0, NEG).astype(jnp.float32)
    nb = L // BLOCK
    qn_b = q_nope.reshape(B, nb, BLOCK, MLA_HEADS, MLA_NOPE).transpose(1, 0, 2, 3, 4)
    qr_b = q_rope.reshape(B, nb, BLOCK, MLA_HEADS, MLA_ROPE).transpose(1, 0, 2, 3, 4)

    def one_block(args):
        qn, qr = args
        s = (jnp.einsum('bqhd,bkhd->bhqk', qn, k_nope).astype(jnp.float32)
             + jnp.einsum('bqhr,bkr->bhqk', qr, k_r).astype(jnp.float32)) * scale + bias
        p = jax.nn.softmax(s, axis=-1)
        return jnp.einsum('bhqk,bkhd->bqhd', p.astype(v.dtype), v)

    o = lax.map(one_block, (qn_b, qr_b))
    return o.transpose(1, 0, 2, 3, 4).reshape(B, L, MLA_HEADS * MLA_V)


def window_gqa(q, k, v, pos, sink):
    B, L, _ = q.shape
    nb = L // BLOCK
    q = rope(q.reshape(B, L, SWA_HEADS, SWA_HEAD_DIM), pos)
    q = q.reshape(B, nb, BLOCK, SWA_KV_HEADS, SWA_GROUP, SWA_HEAD_DIM)
    k = rope(k.reshape(B, L, SWA_KV_HEADS, SWA_HEAD_DIM), pos)
    v = v.reshape(B, L, SWA_KV_HEADS, SWA_HEAD_DIM)
    k_meta = k[:, LEAD_PAD:BLOCK]
    v_meta = v[:, LEAD_PAD:BLOCK]

    def band(t):
        tb = t.reshape(B, nb, BLOCK, SWA_KV_HEADS, SWA_HEAD_DIM)
        tp = jnp.pad(tb, ((0, 0), (1, 1), (0, 0), (0, 0), (0, 0)))
        return jnp.concatenate([tp[:, :-2], tp[:, 1:-1], tp[:, 2:]], axis=2)

    kb, vb = band(k), band(v)
    qi = jnp.arange(L).reshape(nb, BLOCK)
    ki = (jnp.arange(nb)[:, None] - 1) * BLOCK + jnp.arange(3 * BLOCK)[None, :]
    ok = ((ki[:, None, :] >= BLOCK) & (ki[:, None, :] < L)
          & (jnp.abs(qi[:, :, None] - ki[:, None, :]) <= WINDOW))
    scale = SWA_HEAD_DIM ** -0.5
    s_band = jnp.einsum('bnqhgd,bnchd->bnhgqc', q, kb).astype(jnp.float32) * scale
    s_band = jnp.where(ok[None, :, None, None, :, :], s_band, NEG)
    s_meta = jnp.einsum('bnqhgd,bmhd->bnhgqm', q, k_meta).astype(jnp.float32) * scale
    s_sink = jnp.broadcast_to(
        sink.astype(jnp.float32).reshape(SWA_KV_HEADS, SWA_GROUP)[None, None, :, :, None, None],
        s_meta.shape[:-1] + (1,))
    p = jax.nn.softmax(jnp.concatenate([s_band, s_meta, s_sink], axis=-1), axis=-1)
    p_band = p[..., :3 * BLOCK].astype(v.dtype)
    p_meta = p[..., 3 * BLOCK:3 * BLOCK + N_META].astype(v.dtype)
    o = (jnp.einsum('bnhgqc,bnchd->bnqhgd', p_band, vb)
         + jnp.einsum('bnhgqm,bmhd->bnqhgd', p_meta, v_meta))
    return o.reshape(B, L, SWA_HEADS * SWA_HEAD_DIM)


def encoder_layer(x, pos, key_ok,
                  ffn1_pre_g, ffn1_w_in, ffn1_w_out, ffn1_post_g,
                  mix_pre_g, w_in, q_norm_g, w_uq, kv_norm_g, w_ukv, sink,
                  w_o_a, w_o_b, w_out, mix_post_g,
                  ffn2_pre_g, ffn2_w_in, ffn2_w_out, ffn2_post_g):
    x = x + 0.5 * rms_norm(swiglu(rms_norm(x, ffn1_pre_g), ffn1_w_in, ffn1_w_out), ffn1_post_g)
    h = rms_norm(x, mix_pre_g)
    proj = h @ w_in
    splits = np.cumsum(COL_SIZES)[:-1].tolist()
    c_q, c_kv, k_r, q_s, k_s, v_s, g_a, g_b = jnp.split(proj, splits, axis=-1)
    y_a = mla(c_q, c_kv, k_r, pos, key_ok, q_norm_g, w_uq, kv_norm_g, w_ukv) @ w_o_a
    y_b = window_gqa(q_s, k_s, v_s, pos, sink) @ w_o_b
    merged = jax.nn.sigmoid(g_a) * y_a + jax.nn.sigmoid(g_b) * y_b
    x = x + rms_norm(merged @ w_out, mix_post_g)
    x = x + 0.5 * rms_norm(swiglu(rms_norm(x, ffn2_pre_g), ffn2_w_in, ffn2_w_out), ffn2_post_g)
    return x


def run_trunk(x, meta_tokens, weights):
    B, S, D = x.shape
    lead = jnp.concatenate([jnp.zeros((LEAD_PAD, D), x.dtype), meta_tokens.astype(x.dtype)], axis=0)
    h = jnp.concatenate([jnp.broadcast_to(lead[None], (B, BLOCK, D)), x], axis=1)
    L = S + BLOCK
    pos = jnp.arange(L) - LEAD_PAD
    key_ok = pos >= 0
    for l in range(DEPTH):
        h = encoder_layer(h, pos, key_ok, *[w[l] for w in weights])
    return h[:, BLOCK:]


def setup_inputs(seed: int = 0) -> dict:
    key = jax.random.key(seed)
    ks = jax.random.split(key, 24)

    def w(k, shape, fan_in):
        return jax.random.normal(k, shape, jnp.float32) * fan_in ** -0.5

    def gain(k, n):
        return 1.0 + 0.01 * jax.random.normal(k, (DEPTH, n), jnp.float32)

    return {
        "x_prompt": jax.random.normal(ks[0], (BATCH, SEQ, D_MODEL), jnp.float32),
        "x_sample": jax.random.normal(ks[1], (DEC_BATCH, DEC_SEQ, D_MODEL), jnp.float32),
        "meta_tokens": jax.random.normal(ks[2], (N_META, D_MODEL), jnp.float32),
        "ffn1_pre_g": gain(ks[3], D_MODEL),
        "ffn1_w_in": w(ks[4], (DEPTH, D_MODEL, 2 * D_FF), D_MODEL),
        "ffn1_w_out": w(ks[5], (DEPTH, D_FF, D_MODEL), D_FF),
        "ffn1_post_g": gain(ks[6], D_MODEL),
        "mix_pre_g": gain(ks[7], D_MODEL),
        "w_in": w(ks[8], (DEPTH, D_MODEL, D_IN), D_MODEL),
        "q_norm_g": gain(ks[9], MLA_Q_LORA),
        "w_uq": w(ks[10], (DEPTH, MLA_Q_LORA, MLA_HEADS * (MLA_NOPE + MLA_ROPE)), MLA_Q_LORA),
        "kv_norm_g": gain(ks[11], MLA_KV_LORA),
        "w_ukv": w(ks[12], (DEPTH, MLA_KV_LORA, MLA_HEADS * (MLA_NOPE + MLA_V)), MLA_KV_LORA),
        "sink": 0.5 * jax.random.normal(ks[13], (DEPTH, SWA_HEADS), jnp.float32),
        "w_o_a": w(ks[14], (DEPTH, MLA_HEADS * MLA_V, D_MODEL), MLA_HEADS * MLA_V),
        "w_o_b": w(ks[15], (DEPTH, SWA_HEADS * SWA_HEAD_DIM, D_MODEL), SWA_HEADS * SWA_HEAD_DIM),
        "w_out": w(ks[16], (DEPTH, D_MODEL, D_MODEL), D_MODEL),
        "mix_post_g": gain(ks[17], D_MODEL),
        "ffn2_pre_g": gain(ks[18], D_MODEL),
        "ffn2_w_in": w(ks[19], (DEPTH, D_MODEL, 2 * D_FF), D_MODEL),
        "ffn2_w_out": w(ks[20], (DEPTH, D_FF, D_MODEL), D_FF),
        "ffn2_post_g": gain(ks[21], D_MODEL),
    }


def reference(x_prompt, x_sample, meta_tokens,
              ffn1_pre_g, ffn1_w_in, ffn1_w_out, ffn1_post_g,
              mix_pre_g, w_in, q_norm_g, w_uq, kv_norm_g, w_ukv, sink,
              w_o_a, w_o_b, w_out, mix_post_g,
              ffn2_pre_g, ffn2_w_in, ffn2_w_out, ffn2_post_g):
    weights = (ffn1_pre_g, ffn1_w_in, ffn1_w_out, ffn1_post_g,
               mix_pre_g, w_in, q_norm_g, w_uq, kv_norm_g, w_ukv, sink,
               w_o_a, w_o_b, w_out, mix_post_g,
               ffn2_pre_g, ffn2_w_in, ffn2_w_out, ffn2_post_g)
    y_prompt = run_trunk(x_prompt, meta_tokens, weights)
    y_sample = run_trunk(x_sample, meta_tokens, weights)
    return (y_prompt, y_sample)
```

```cpp
#include <hip/hip_runtime.h>
#include <hip/hip_cooperative_groups.h>
#include <cstdint>
#include <cstdio>
namespace cg = cooperative_groups;

constexpr int DM = 1024, DFF = 2816, MH = 16384;
constexpr float RMS_EPS = 1e-6f;
constexpr float LOG2E_F = 1.4426950408889634f;
constexpr float SC_A = 0.10206207261596577f * 1.4426950408889634f;
constexpr float SC_B = 0.125f * 1.4426950408889634f;
constexpr float ROPE_L2T = 13.287712379549449f;

__device__ __forceinline__ void rope_cs(int pos, float inv, float& c, float& s) {
    const double rev = (double)((float)pos * inv) * 0.15915494309189535;
    const float f = (float)(rev - __builtin_rint(rev));
    s = __builtin_amdgcn_sinf(f); c = __builtin_amdgcn_cosf(f);
}
__device__ __forceinline__ float sigm_f(float g) { return __builtin_amdgcn_rcpf(1.f + __builtin_amdgcn_exp2f(-g * LOG2E_F)); }
__device__ __forceinline__ float bf2f(unsigned short b) { return __uint_as_float(((unsigned)b) << 16); }

constexpr int NWAVES = 8, LDS_BYTES = 147456;
constexpr size_t MiB = 1u << 20, KiB = 1u << 10;
constexpr size_t WS_SSQQ = 0, WS_SSQKV = 128 * KiB, WS_XNM = 256 * KiB, WS_FM = 320 * KiB, WS_H2M = 384 * KiB, WS_RAWP = 448 * KiB, WS_RAW1 = 704 * KiB,
                 WS_KMETA = 1088 * KiB, WS_VMETA = 1184 * KiB, WS_KSMETA = 1248 * KiB, WS_VSMETA = 1264 * KiB, WS_RAWKV = 1280 * KiB  ;
constexpr size_t WS_W1T = 2 * MiB, WS_W2T = 13 * MiB, WS_W1T2 = 18 * MiB + 512 * KiB, WS_W2T2 = 29 * MiB + 512 * KiB, WS_WINT = 35 * MiB, WS_WUQT = 42 * MiB, WS_WUKVT = 42 * MiB + 768 * KiB,
                 WS_WOAT = 43 * MiB + 512 * KiB, WS_WOBT = 45 * MiB, WS_WOUTT = 46 * MiB;
constexpr size_t WS_XN = 48 * MiB, WS_R = 80 * MiB, WS_END = 254 * MiB;
constexpr size_t R_ACT = WS_R, R_F2 = WS_R + 88 * MiB;
constexpr size_t R_GA = WS_R, R_GB = WS_R + 32 * MiB, R_QS = WS_R + 64 * MiB, R_QA = WS_R + 80 * MiB, R_KF = WS_R + 104 * MiB, R_VT = WS_R + 128 * MiB, R_KS = WS_R + 144 * MiB, R_VTS = WS_R + 148 * MiB,
                 R_CQ = WS_R + 152 * MiB, R_CKV = WS_R + 164 * MiB, R_T = WS_R + 104 * MiB, R_Y = WS_R;
constexpr int N_WIN = 3584;

namespace pg8 {
#define PG8_LAS __attribute__((address_space(3)))
typedef unsigned short bf16_t;
typedef short bf16x8 __attribute__((ext_vector_type(8)));
typedef float f32x4 __attribute__((ext_vector_type(4)));
typedef unsigned u32x4 __attribute__((ext_vector_type(4)));
constexpr int BM = 256, BK = 64, HALF = 128, HTB = HALF * BK * 2  , STAGE_BYTES = 8 * HTB, NXCD = 8, WGM = 8;

__host__ __device__ __forceinline__ int lds_byte(int r, int c) { const int st = (r >> 4) * 2 + (c >> 5), rr = r & 15, cc = c & 31, ob = rr * 64 + cc * 2; return st * 1024 + (ob ^ (((ob >> 9) & 1) << 5)); }
__host__ __device__ __forceinline__ void stage_rc(int b, int& R, int& C) { const int st = b / 1024, sb = b % 1024, swz = sb ^ (((sb >> 9) & 1) << 5); R = (st >> 1) * 16 + swz / 64; C = (st & 1) * 32 + (swz % 64) / 2; }
__host__ __device__ __forceinline__ int perm32(int rho) { const int n = rho >> 4, i = rho & 15; return 8 * (i >> 2) + 4 * n + (i & 3); }

struct Unit { int pm, pn; };
struct Gemm { const bf16_t* A; const bf16_t* Bt; int M, N, K; };

struct StaticOrder {
    int nM, nN, nwg, G, c;
    __host__ __device__ void init(int M, int N, int G_, int c_) { nM = M / BM; nN = N / BM; nwg = nM * nN; G = G_; c = c_; }
    __host__ __device__ bool next(int i, Unit& u) const {
        const long L = (long)i * G + c; if (L >= nwg) return false;
        int wgid = (int)L; { const int q = nwg / NXCD, r = nwg % NXCD, xcd = wgid % NXCD, off = wgid / NXCD; wgid = (xcd < r ? xcd * (q + 1) : r * (q + 1) + (xcd - r) * q) + off; }
        const int nig = WGM * nN, gid = wgid / nig, fm = gid * WGM, gsz = (nM - fm) < WGM ? (nM - fm) : WGM;
        u.pm = fm + ((wgid % nig) % gsz); u.pn = (wgid % nig) / gsz; return true;
    }
    __device__ __forceinline__ void a_ready(const Unit&) const {}
    __device__ __forceinline__ void done(const Unit&) const {}
};

typedef float f32x2_c __attribute__((ext_vector_type(2))); typedef __bf16 bf16x2_c __attribute__((ext_vector_type(2)));
__device__ __forceinline__ unsigned cvt_pk_bf16(float lo, float hi) { f32x2_c v = {lo, hi}; bf16x2_c b = __builtin_convertvector(v, bf16x2_c); return __builtin_bit_cast(unsigned, b); }
typedef float f32x2 __attribute__((ext_vector_type(2)));
typedef unsigned u32x2 __attribute__((ext_vector_type(2)));
__device__ __forceinline__ u32x4 pack8(const f32x4 a, const f32x4 b) { u32x4 w; w.x = cvt_pk_bf16(a[0], a[1]); w.y = cvt_pk_bf16(a[2], a[3]); w.z = cvt_pk_bf16(b[0], b[1]); w.w = cvt_pk_bf16(b[2], b[3]); return w; }
__device__ __forceinline__ void unpack8(const u32x4 w, f32x4& a, f32x4& b) {
    a[0] = __uint_as_float(w.x << 16); a[1] = __uint_as_float(w.x & 0xffff0000u); a[2] = __uint_as_float(w.y << 16); a[3] = __uint_as_float(w.y & 0xffff0000u);
    b[0] = __uint_as_float(w.z << 16); b[1] = __uint_as_float(w.z & 0xffff0000u); b[2] = __uint_as_float(w.w << 16); b[3] = __uint_as_float(w.w & 0xffff0000u); }
__device__ __forceinline__ void rope8(f32x4& a, f32x4& b, int pos, const float (&inv)[4]) {
    float c, s, x1, x2;
    rope_cs(pos, inv[0], c, s); x1 = a[0]; x2 = a[1]; a[0] = x1 * c - x2 * s; a[1] = x2 * c + x1 * s;
    rope_cs(pos, inv[1], c, s); x1 = a[2]; x2 = a[3]; a[2] = x1 * c - x2 * s; a[3] = x2 * c + x1 * s;
    rope_cs(pos, inv[2], c, s); x1 = b[0]; x2 = b[1]; b[0] = x1 * c - x2 * s; b[1] = x2 * c + x1 * s;
    rope_cs(pos, inv[3], c, s); x1 = b[2]; x2 = b[3]; b[2] = x1 * c - x2 * s; b[3] = x2 * c + x1 * s;
}

struct EpiSwiglu {
    static constexpr bool PERM = true, AFTER_DRAIN = false;
    unsigned char* ws;
    __device__ __forceinline__ void operator()(const f32x4 (&acc)[2][2][4][2], const Unit& u, int wr, int wc_, int fr_, int fq_) const {
        int wc = wc_, fr = fr_, fq = fq_; asm volatile("" : "+s"(wc), "+v"(fr), "+v"(fq));
        bf16_t* O = (bf16_t*)(ws + R_ACT);
        const int col = u.pn * 128 + wc * 32 + fq * 8;
#pragma unroll
        for (int ai = 0; ai < 2; ++ai)
#pragma unroll
            for (int m = 0; m < 4; ++m) {
                const int row = u.pm * BM + ai * HALF + wr * 64 + m * 16 + fr;
                f32x4 o0, o1;
#pragma unroll
                for (int j = 0; j < 4; ++j) { o0[j] = acc[ai][0][m][0][j] * sigm_f(acc[ai][0][m][0][j]) * acc[ai][1][m][0][j]; o1[j] = acc[ai][0][m][1][j] * sigm_f(acc[ai][0][m][1][j]) * acc[ai][1][m][1][j]; }
                *(u32x4*)(O + (size_t)row * DFF + col) = pack8(o0, o1);
            }
    }
};
struct EpiF32 {
    static constexpr bool PERM = true, AFTER_DRAIN = false;
    float* O; int ldc;
    __device__ __forceinline__ void operator()(const f32x4 (&acc)[2][2][4][2], const Unit& u, int wr, int wc_, int fr_, int fq_) const {
        int wc = wc_, fr = fr_, fq = fq_; asm volatile("" : "+s"(wc), "+v"(fr), "+v"(fq));
#pragma unroll
        for (int ai = 0; ai < 2; ++ai)
#pragma unroll
            for (int m = 0; m < 4; ++m) {
                float* rp = O + (size_t)(u.pm * BM + ai * HALF + wr * 64 + m * 16 + fr) * ldc + u.pn * BM + wc * 32 + fq * 8;
#pragma unroll
                for (int bj = 0; bj < 2; ++bj) { *(f32x4*)(rp + bj * HALF) = acc[ai][bj][m][0]; *(f32x4*)(rp + bj * HALF + 4) = acc[ai][bj][m][1]; }
            }
    }
};
struct EpiProj {
    static constexpr bool PERM = true, AFTER_DRAIN = false;
    unsigned char* ws; int rofs, smask;
    __device__ __forceinline__ void operator()(const f32x4 (&acc)[2][2][4][2], const Unit& u, int wr, int wc_, int fr_, int fq_) const {
        int wc = wc_, fr = fr_, fq = fq_; asm volatile("" : "+s"(wc), "+v"(fr), "+v"(fq));
        bf16_t *CQ = (bf16_t*)(ws + R_CQ), *CKV = (bf16_t*)(ws + R_CKV), *QS = (bf16_t*)(ws + R_QS), *GA = (bf16_t*)(ws + R_GA), *GB = (bf16_t*)(ws + R_GB), *Kf = (bf16_t*)(ws + R_KF), *Ks = (bf16_t*)(ws + R_KS), *Vts = (bf16_t*)(ws + R_VTS);
        float *ssq_q = (float*)(ws + WS_SSQQ) + rofs, *ssq_kv = (float*)(ws + WS_SSQKV) + rofs;
        const int pn = u.pn, rbase = u.pm * BM + wr * 64 + fr, cl = wc * 32 + fq * 8;
        if (pn <= 2) {
            bf16_t* dst = (pn == 2) ? CKV : CQ; const int ld = (pn == 2) ? 256 : 384, cbase = (pn == 1) ? 256 : 0; float* ssq = (pn == 2) ? ssq_kv : ssq_q;
#pragma unroll
            for (int ai = 0; ai < 2; ++ai)
#pragma unroll
                for (int m = 0; m < 4; ++m) {
                    const int row = rbase + ai * HALF + m * 16; float s = 0.f;
#pragma unroll
                    for (int bj = 0; bj < 2; ++bj) if (bj == 0 || pn != 1) {
                        const f32x4 a = acc[ai][bj][m][0], b = acc[ai][bj][m][1];
                        s += (a[0] * a[0] + a[1] * a[1]) + (a[2] * a[2] + a[3] * a[3]) + (b[0] * b[0] + b[1] * b[1]) + (b[2] * b[2] + b[3] * b[3]);
                        *(u32x4*)(dst + (size_t)row * ld + cbase + bj * HALF + cl) = pack8(a, b);
                    }
                    s += __shfl_xor(s, 16); s += __shfl_xor(s, 32);
                    if (fq == 0) atomicAdd(ssq + row, s);
                }
            if (pn == 1) {
                const int g = wc >> 1, c = (wc & 1) * 32 + fq * 8; float inv[4];
#pragma unroll
                for (int j = 0; j < 4; ++j) inv[j] = __builtin_amdgcn_exp2f(-(float)(c / 2 + j) * (ROPE_L2T / 32.f));
#pragma unroll
                for (int ai = 0; ai < 2; ++ai)
#pragma unroll
                    for (int m = 0; m < 4; ++m) {
                        const int row = rbase + ai * HALF + m * 16; f32x4 a = acc[ai][1][m][0], b = acc[ai][1][m][1];
                        rope8(a, b, 16 + (row & smask), inv);
                        *(u32x4*)(Ks + ((size_t)g * MH + row) * 64 + c) = pack8(a, b);
                    }
            }
        } else if (pn <= 4) {
            const int c = (wc & 1) * 32 + fq * 8; float inv[4];
#pragma unroll
            for (int j = 0; j < 4; ++j) inv[j] = __builtin_amdgcn_exp2f(-(float)(c / 2 + j) * (ROPE_L2T / 32.f));
#pragma unroll
            for (int ai = 0; ai < 2; ++ai)
#pragma unroll
                for (int m = 0; m < 4; ++m) {
                    const int row = rbase + ai * HALF + m * 16;
#pragma unroll
                    for (int bj = 0; bj < 2; ++bj) {
                        f32x4 a = acc[ai][bj][m][0], b = acc[ai][bj][m][1];
                        rope8(a, b, 16 + (row & smask), inv);
                        *(u32x4*)(QS + (size_t)row * 512 + (pn - 3) * 256 + bj * HALF + cl) = pack8(a * SC_B, b * SC_B);
                    }
                }
        } else if (pn == 5) {
            {
                const int g = wc >> 1, d0 = (wc & 1) * 32 + fq * 8;
#pragma unroll
                for (int ai = 0; ai < 2; ++ai)
#pragma unroll
                    for (int m = 0; m < 4; ++m) {
                        const int row = rbase + ai * HALF + m * 16; const u32x4 w = pack8(acc[ai][0][m][0], acc[ai][0][m][1]);
                        bf16_t* vp = Vts + (size_t)(g * 64 + d0) * MH + row;
                        vp[0] = (bf16_t)(w.x & 0xffffu); vp[MH] = (bf16_t)(w.x >> 16); vp[2 * (size_t)MH] = (bf16_t)(w.y & 0xffffu); vp[3 * (size_t)MH] = (bf16_t)(w.y >> 16);
                        vp[4 * (size_t)MH] = (bf16_t)(w.z & 0xffffu); vp[5 * (size_t)MH] = (bf16_t)(w.z >> 16); vp[6 * (size_t)MH] = (bf16_t)(w.w & 0xffffu); vp[7 * (size_t)MH] = (bf16_t)(w.w >> 16);
                    }
            }
            if (wc == 0) {
                float inv[4];
#pragma unroll
                for (int j = 0; j < 4; ++j) inv[j] = __builtin_amdgcn_exp2f(-(float)(fq * 4 + j) * (ROPE_L2T / 16.f));
#pragma unroll
                for (int ai = 0; ai < 2; ++ai)
#pragma unroll
                    for (int m = 0; m < 4; ++m) {
                        const int row = rbase + ai * HALF + m * 16; f32x4 a = acc[ai][1][m][0], b = acc[ai][1][m][1];
                        rope8(a, b, 16 + (row & smask), inv); const u32x4 w = pack8(a, b);
#pragma unroll
                        for (int h = 0; h < 8; ++h) *(u32x4*)(Kf + ((size_t)h * MH + row) * 96 + 64 + fq * 8) = w;
                    }
            }
        } else {
            bf16_t* dst = (pn < 10) ? GA : GB; const int cb = ((pn < 10) ? (pn - 6) : (pn - 10)) * 256;
#pragma unroll
            for (int ai = 0; ai < 2; ++ai)
#pragma unroll
                for (int m = 0; m < 4; ++m) {
                    const int row = rbase + ai * HALF + m * 16;
#pragma unroll
                    for (int bj = 0; bj < 2; ++bj) {
                        f32x4 a = acc[ai][bj][m][0], b = acc[ai][bj][m][1];
#pragma unroll
                        for (int j = 0; j < 4; ++j) { a[j] = sigm_f(a[j]); b[j] = sigm_f(b[j]); }
                        *(u32x4*)(dst + (size_t)row * DM + cb + bj * HALF + cl) = pack8(a, b);
                    }
                }
        }
    }
};
struct EpiQ {
    static constexpr bool PERM = true, AFTER_DRAIN = false;
    unsigned char* ws; int rofs, smask;
    __device__ __forceinline__ void operator()(const f32x4 (&acc)[2][2][4][2], const Unit& u, int wr, int wc_, int fr_, int fq_) const {
        int wc = wc_, fr = fr_, fq = fq_; asm volatile("" : "+s"(wc), "+v"(fr), "+v"(fq));
        bf16_t* QA = (bf16_t*)(ws + R_QA); const float* ssq_q = (const float*)(ws + WS_SSQQ) + rofs;
        const int rbase = u.pm * BM + wr * 64 + fr;
        float rs[2][4];
#pragma unroll
        for (int ai = 0; ai < 2; ++ai)
#pragma unroll
            for (int m = 0; m < 4; ++m) rs[ai][m] = rsqrtf(ssq_q[rbase + ai * HALF + m * 16] * (1.f / 384.f) + RMS_EPS) * SC_A;
#pragma unroll
        for (int bj = 0; bj < 2; ++bj) {
            const int col = u.pn * BM + bj * HALF + wc * 32 + fq * 8, cih = col % 96; const bool isr = cih >= 64; float inv[4];
#pragma unroll
            for (int j = 0; j < 4; ++j) inv[j] = __builtin_amdgcn_exp2f(-(float)((cih - 64) / 2 + j) * (ROPE_L2T / 16.f));
#pragma unroll
            for (int ai = 0; ai < 2; ++ai)
#pragma unroll
                for (int m = 0; m < 4; ++m) {
                    const int row = rbase + ai * HALF + m * 16; f32x4 a = acc[ai][bj][m][0] * rs[ai][m], b = acc[ai][bj][m][1] * rs[ai][m];
                    if (isr) rope8(a, b, 16 + (row & smask), inv);
                    *(u32x4*)(QA + (size_t)row * 768 + col) = pack8(a, b);
                }
        }
    }
};
struct EpiKV {
    static constexpr bool PERM = true, AFTER_DRAIN = false;
    unsigned char* ws; int rofs;
    __device__ __forceinline__ void operator()(const f32x4 (&acc)[2][2][4][2], const Unit& u, int wr, int wc_, int fr_, int fq_) const {
        int wc = wc_, fr = fr_, fq = fq_; asm volatile("" : "+s"(wc), "+v"(fr), "+v"(fq));
        bf16_t *Kf = (bf16_t*)(ws + R_KF), *Vt = (bf16_t*)(ws + R_VT); const float* ssq_kv = (const float*)(ws + WS_SSQKV) + rofs;
        const int rbase = u.pm * BM + wr * 64 + fr;
#pragma unroll
        for (int ai = 0; ai < 2; ++ai)
#pragma unroll
            for (int m = 0; m < 4; ++m) {
                const int row = rbase + ai * HALF + m * 16; const float rs = rsqrtf(ssq_kv[row] * (1.f / 256.f) + RMS_EPS);
#pragma unroll
                for (int bj = 0; bj < 2; ++bj) {
                    const int col = (u.pn & 1) * BM + bj * HALF + wc * 32 + fq * 8, h = col >> 6, d0 = col & 63;
                    const u32x4 w = pack8(acc[ai][bj][m][0] * rs, acc[ai][bj][m][1] * rs);
                    if (u.pn < 2) { *(u32x4*)(Kf + ((size_t)h * MH + row) * 96 + d0) = w; }
                    else { bf16_t* vp = Vt + (size_t)(h * 64 + d0) * MH + row;
                        vp[0] = (bf16_t)(w.x & 0xffffu); vp[MH] = (bf16_t)(w.x >> 16); vp[2 * (size_t)MH] = (bf16_t)(w.y & 0xffffu); vp[3 * (size_t)MH] = (bf16_t)(w.y >> 16);
                        vp[4 * (size_t)MH] = (bf16_t)(w.z & 0xffffu); vp[5 * (size_t)MH] = (bf16_t)(w.z >> 16); vp[6 * (size_t)MH] = (bf16_t)(w.w & 0xffffu); vp[7 * (size_t)MH] = (bf16_t)(w.w >> 16); }
                }
            }
    }
};
template <bool SECOND> struct EpiGate {
    static constexpr bool PERM = true, AFTER_DRAIN = false;
    unsigned char* ws;
    __device__ __forceinline__ void operator()(const f32x4 (&acc)[2][2][4][2], const Unit& u, int wr, int wc_, int fr_, int fq_) const {
        int wc = wc_, fr = fr_, fq = fq_; asm volatile("" : "+s"(wc), "+v"(fr), "+v"(fq));
        const bf16_t* G = (const bf16_t*)(ws + (SECOND ? R_GB : R_GA)); bf16_t* T = (bf16_t*)(ws + R_T); bf16_t* O = (bf16_t*)(ws + WS_XN);
#pragma unroll
        for (int ai = 0; ai < 2; ++ai)
#pragma unroll
            for (int m = 0; m < 4; ++m)
#pragma unroll
                for (int bj = 0; bj < 2; ++bj) {
                    const size_t off = (size_t)(u.pm * BM + ai * HALF + wr * 64 + m * 16 + fr) * DM + u.pn * BM + bj * HALF + wc * 32 + fq * 8;
                    f32x4 ga, gb; unpack8(*(const u32x4*)(G + off), ga, gb);
                    f32x4 a = acc[ai][bj][m][0] * ga, b = acc[ai][bj][m][1] * gb;
                    if (SECOND) { f32x4 ta, tb; unpack8(*(const u32x4*)(T + off), ta, tb); a += ta; b += tb; *(u32x4*)(O + off) = pack8(a, b); }
                    else *(u32x4*)(T + off) = pack8(a, b);
                }
    }
};
template <class Epi, class Sched, bool ALIGN_EPI = false, bool SP2 = false>
__device__ __forceinline__ void gemm_phase(PG8_LAS unsigned char* lds, const Gemm g, const Sched& S, const Epi& E) {
    int tid_ = threadIdx.x, K_ = g.K; asm volatile("" : "+v"(tid_), "+s"(K_));
    const int tid = tid_, wid = __builtin_amdgcn_readfirstlane(tid >> 6), lane = tid & 63, wr = wid >> 2, wc = wid & 3, fr = lane & 15, fq = lane >> 4;
    const int K = K_, nt = K / BK;
    unsigned voffA[2], voffB[2];
#pragma unroll
    for (int i = 0; i < 2; ++i) { int R, C; stage_rc(tid * 16 + i * 8192, R, C); const int Rb = Epi::PERM ? ((R & ~31) + perm32(R & 31)) : R;
        voffA[i] = (unsigned)(R * K + C) * 2u; voffB[i] = (unsigned)(Rb * K + C) * 2u; }
    const size_t kstep = (size_t)(BK * 2);
    const size_t hstep = (size_t)HALF * K * 2;
    const size_t tstep = 2 * hstep;
    const unsigned ldsw = (unsigned)wid * 1024u;
    const int aoff = lds_byte(wr * 64 + fr, fq * 8), boff = lds_byte(wc * 32 + fr, fq * 8);
#define PG8_SA(b, h) (((b) * 2 + (h)) * HTB)
#define PG8_SB(b, h) ((4 + (b) * 2 + (h)) * HTB)
#define PG8_STAGE(bufoff, gbase, voff) do { _Pragma("unroll") for (int _i = 0; _i < 2; ++_i) \
        __builtin_amdgcn_global_load_lds((const unsigned*)((const char*)(gbase) + (voff)[_i]), (PG8_LAS unsigned*)(lds + (bufoff) + ldsw + _i * 8192), 16, 0, 0); } while (0)
#define PG8_LDA(dst, b, h) do { _Pragma("unroll") for (int m = 0; m < 4; ++m) _Pragma("unroll") for (int k = 0; k < 2; ++k) dst[m][k] = *(const PG8_LAS bf16x8*)(lds + PG8_SA(b, h) + aoff + m * 2048 + k * 1024); } while (0)
#define PG8_LDB(dst, b, h) do { _Pragma("unroll") for (int n = 0; n < 2; ++n) _Pragma("unroll") for (int k = 0; k < 2; ++k) dst[n][k] = *(const PG8_LAS bf16x8*)(lds + PG8_SB(b, h) + boff + n * 2048 + k * 1024); } while (0)
#define PG8_MMA(ai, bj, At, Bt) do { __builtin_amdgcn_s_setprio(1); _Pragma("unroll") for (int m = 0; m < 4; ++m) _Pragma("unroll") for (int n = 0; n < 2; ++n) _Pragma("unroll") for (int k = 0; k < 2; ++k) \
        acc[ai][bj][m][n] = __builtin_amdgcn_mfma_f32_16x16x32_bf16(Bt[n][k], At[m][k], acc[ai][bj][m][n], 0, 0, 0); __builtin_amdgcn_s_setprio(0); } while (0)
#define PG8_WAIT_V(n) asm volatile("s_waitcnt vmcnt(" #n ")" ::: "memory")
#define PG8_WAIT_L(n) asm volatile("s_waitcnt lgkmcnt(" #n ")" ::: "memory")
#define PG8_BAR __builtin_amdgcn_s_barrier()
#define PG8_SCHED __builtin_amdgcn_sched_barrier(0)
    Unit cur, nxt; int ui = 0;
    if (!S.next(0, cur)) return;
    f32x4 acc[2][2][4][2];
#pragma unroll
    for (int a = 0; a < 2; ++a)
#pragma unroll
        for (int b = 0; b < 2; ++b)
#pragma unroll
            for (int m = 0; m < 4; ++m)
#pragma unroll
                for (int n = 0; n < 2; ++n) acc[a][b][m][n] = (f32x4){0.f, 0.f, 0.f, 0.f};
    bf16x8 At[4][2], B0[2][2], B1[2][2];
    const char* cA = (const char*)g.A + (size_t)cur.pm * tstep; const char* cB = (const char*)g.Bt + (size_t)cur.pn * tstep;
    S.a_ready(cur);
    if constexpr (SP2) {
        PG8_STAGE(PG8_SB(0, 0), cB, voffB); PG8_STAGE(PG8_SB(0, 1), cB + hstep, voffB); PG8_STAGE(PG8_SA(0, 0), cA, voffA); PG8_STAGE(PG8_SA(0, 1), cA + hstep, voffA);
        if (wr == 1) PG8_BAR;
        PG8_WAIT_V(2); PG8_BAR;
        PG8_STAGE(PG8_SB(1, 0), cB + kstep, voffB); PG8_STAGE(PG8_SA(1, 0), cA + kstep, voffA); PG8_STAGE(PG8_SB(1, 1), cB + hstep + kstep, voffB);
        PG8_WAIT_V(6); PG8_BAR;
    } else {
        PG8_STAGE(PG8_SB(0, 0), cB, voffB); PG8_STAGE(PG8_SA(0, 0), cA, voffA); PG8_STAGE(PG8_SB(0, 1), cB + hstep, voffB); PG8_STAGE(PG8_SA(0, 1), cA + hstep, voffA);
        if (wr == 1) PG8_BAR;
        PG8_WAIT_V(4); PG8_BAR;
        PG8_STAGE(PG8_SB(1, 0), cB + kstep, voffB); PG8_STAGE(PG8_SA(1, 0), cA + kstep, voffA); PG8_STAGE(PG8_SB(1, 1), cB + hstep + kstep, voffB);
        PG8_WAIT_V(6); PG8_BAR;
    }
    for (;;) {
        const bool has_next = S.next(ui + 1, nxt);
        const char* nA = has_next ? (const char*)g.A + (size_t)nxt.pm * tstep : cA; const char* nB = has_next ? (const char*)g.Bt + (size_t)nxt.pn * tstep : cB;
        for (int t = 0; t < nt; t += 2) {
            const bool last = (t == nt - 2);
            const char* a1 = cA + (size_t)(t + 1) * kstep;
            const char* a2 = last ? nA : cA + (size_t)(t + 2) * kstep; const char* b2 = last ? nB : cB + (size_t)(t + 2) * kstep;
            const char* a3 = a2 + kstep; const char* b3 = b2 + kstep;
            if (last && has_next) S.a_ready(nxt);
            if constexpr (SP2) {
            PG8_LDB(B0, 0, 0); PG8_LDB(B1, 0, 1); PG8_SCHED; PG8_LDA(At, 0, 0); PG8_STAGE(PG8_SA(1, 1), a1 + hstep, voffA);
            PG8_WAIT_V(8); PG8_WAIT_L(0); PG8_BAR; PG8_MMA(0, 0, At, B0); PG8_MMA(0, 1, At, B1); PG8_BAR; PG8_SCHED;
            PG8_LDA(At, 0, 1); PG8_STAGE(PG8_SB(0, 0), b2, voffB); PG8_STAGE(PG8_SB(0, 1), b2 + hstep, voffB); PG8_STAGE(PG8_SA(0, 0), a2, voffA);
            PG8_WAIT_V(8); PG8_WAIT_L(0); PG8_BAR; PG8_MMA(1, 0, At, B0); PG8_MMA(1, 1, At, B1); PG8_BAR; PG8_SCHED;
            PG8_LDB(B0, 1, 0); PG8_LDB(B1, 1, 1); PG8_SCHED; PG8_LDA(At, 1, 0); PG8_STAGE(PG8_SA(0, 1), a2 + hstep, voffA);
            PG8_WAIT_V(8); PG8_WAIT_L(0); PG8_BAR; PG8_MMA(0, 0, At, B0); PG8_MMA(0, 1, At, B1); PG8_BAR; PG8_SCHED;
            PG8_LDA(At, 1, 1); PG8_STAGE(PG8_SB(1, 0), b3, voffB); PG8_STAGE(PG8_SB(1, 1), b3 + hstep, voffB); PG8_STAGE(PG8_SA(1, 0), a3, voffA);
            PG8_WAIT_V(8); PG8_WAIT_L(0); PG8_BAR; PG8_MMA(1, 0, At, B0); PG8_MMA(1, 1, At, B1); PG8_BAR; PG8_SCHED;
            } else {
            PG8_LDB(B0, 0, 0); PG8_SCHED; PG8_LDA(At, 0, 0); PG8_STAGE(PG8_SA(1, 1), a1 + hstep, voffA);
            PG8_WAIT_L(8); PG8_BAR; PG8_WAIT_L(0); PG8_MMA(0, 0, At, B0); PG8_BAR; PG8_SCHED;
            PG8_LDB(B1, 0, 1); PG8_STAGE(PG8_SB(0, 0), b2, voffB);
            PG8_BAR; PG8_WAIT_L(0); PG8_MMA(0, 1, At, B1); PG8_BAR;
            PG8_LDA(At, 0, 1); PG8_STAGE(PG8_SA(0, 0), a2, voffA);
            PG8_BAR; PG8_WAIT_L(0); PG8_MMA(1, 0, At, B0); PG8_BAR; PG8_SCHED;
            PG8_STAGE(PG8_SB(0, 1), b2 + hstep, voffB);
            PG8_WAIT_V(6); PG8_BAR; PG8_MMA(1, 1, At, B1); PG8_BAR;
            PG8_LDB(B0, 1, 0); PG8_SCHED; PG8_LDA(At, 1, 0); PG8_STAGE(PG8_SA(0, 1), a2 + hstep, voffA);
            PG8_WAIT_L(8); PG8_BAR; PG8_WAIT_L(0); PG8_MMA(0, 0, At, B0); PG8_BAR; PG8_SCHED;
            PG8_LDB(B1, 1, 1); PG8_STAGE(PG8_SB(1, 0), b3, voffB);
            PG8_BAR; PG8_WAIT_L(0); PG8_MMA(0, 1, At, B1); PG8_BAR;
            PG8_LDA(At, 1, 1); PG8_STAGE(PG8_SA(1, 0), a3, voffA);
            PG8_BAR; PG8_WAIT_L(0); PG8_MMA(1, 0, At, B0); PG8_BAR; PG8_SCHED;
            PG8_STAGE(PG8_SB(1, 1), b3 + hstep, voffB);
            PG8_WAIT_V(6); PG8_BAR; PG8_MMA(1, 1, At, B1); PG8_BAR;
            }
        }
        if constexpr (ALIGN_EPI) { if (wr == 0) PG8_BAR; }
        if constexpr (!Epi::AFTER_DRAIN) { E(acc, cur, wr, wc, fr, fq); S.done(cur); }
        if (!has_next) break;
#pragma unroll
        for (int a = 0; a < 2; ++a)
#pragma unroll
            for (int b = 0; b < 2; ++b)
#pragma unroll
                for (int m = 0; m < 4; ++m)
#pragma unroll
                    for (int n = 0; n < 2; ++n) acc[a][b][m][n] = (f32x4){0.f, 0.f, 0.f, 0.f};
        cur = nxt; cA = nA; cB = nB; ++ui;
        if constexpr (ALIGN_EPI) { if (wr == 1) PG8_BAR; }
    }
    PG8_WAIT_V(0);
    if constexpr (!ALIGN_EPI) { if (wr == 0) PG8_BAR; }
    PG8_BAR;
    if constexpr (Epi::AFTER_DRAIN) { E.fused(acc, cur, wr, wc, fr, fq, lds, wid, lane); S.done(cur); }
#undef PG8_SA
#undef PG8_SB
#undef PG8_STAGE
#undef PG8_LDA
#undef PG8_LDB
#undef PG8_MMA
#undef PG8_WAIT_V
#undef PG8_WAIT_L
#undef PG8_BAR
#undef PG8_SCHED
}
}
namespace att {
typedef unsigned short bf16_t;
typedef short bf16x8 __attribute__((ext_vector_type(8)));
typedef short s16x4 __attribute__((ext_vector_type(4)));
typedef float f32x16 __attribute__((ext_vector_type(16)));
typedef unsigned u32x4 __attribute__((ext_vector_type(4)));
typedef unsigned u32x2 __attribute__((ext_vector_type(2)));
#define ATT_LAS __attribute__((address_space(3)))
struct UnitDesc {
    const bf16_t* qptr; bf16_t* optr;
    const bf16_t *kmeta, *vmeta, *kmain, *vmain;
    int t_lo, t_hi, tq; float sinkl2;
};
__device__ __forceinline__ int crow(int r, int hi) { return (r & 3) + 8 * (r >> 2) + 4 * hi; }
typedef float f32x2_t __attribute__((ext_vector_type(2))); typedef __bf16 bf16x2_t __attribute__((ext_vector_type(2)));
__device__ __forceinline__ unsigned cvtpk(float lo, float hi) { f32x2_t v = {lo, hi}; bf16x2_t b = __builtin_convertvector(v, bf16x2_t); return __builtin_bit_cast(unsigned, b); }
__device__ __forceinline__ float swapsum(float v) { auto rr = __builtin_amdgcn_permlane32_swap(__float_as_uint(v), __float_as_uint(v), false, false); return __uint_as_float(rr[0]) + __uint_as_float(rr[1]); }
__device__ __forceinline__ float swapmax(float v) { auto rr = __builtin_amdgcn_permlane32_swap(__float_as_uint(v), __float_as_uint(v), false, false); return fmaxf(__uint_as_float(rr[0]), __uint_as_float(rr[1])); }

template <int DQK, bool BAND>
__device__ __forceinline__ void attn_unit(ATT_LAS unsigned char* lds, const UnitDesc& d) {
    constexpr int KROW = DQK * 2 + 16, VROW = 144, KBUF = 64 * KROW, VBUF = 64 * VROW, KCH = DQK / 8, NKC = 64 * KCH, NDS = DQK / 16;
    int tid_ = threadIdx.x; asm volatile("" : "+v"(tid_));
    const int tid = tid_, lane = tid & 63, r32 = lane & 31, hi = lane >> 5;
    bf16x8 qr[NDS];
#pragma unroll
    for (int ds = 0; ds < NDS; ++ds) qr[ds] = *(const bf16x8*)(d.qptr + ds * 16 + hi * 8);
    f32x16 o0, o1;
#pragma unroll
    for (int r = 0; r < 16; ++r) { o0[r] = 0.f; o1[r] = 0.f; }
    float mrun = -INFINITY, lrun = 0.f;
    u32x4 sk0, sk1 = {0u, 0u, 0u, 0u}, sv;
    const int nt = 1 + (d.t_hi - d.t_lo);
#define ATT_GLOAD(tile) do { const int t_ = (tile); const bf16_t* kt_ = t_ < 0 ? d.kmeta : d.kmain + (size_t)t_ * 64 * DQK; \
        sk0 = *(const u32x4*)(kt_ + tid * 8); if (NKC > 512) { if (tid < NKC - 512) sk1 = *(const u32x4*)(kt_ + (tid + 512) * 8); } \
        const bf16_t* vt_ = t_ < 0 ? d.vmeta : d.vmain + t_ * 64; const int vp_ = t_ < 0 ? 64 : MH; \
        sv = *(const u32x4*)(vt_ + (size_t)(tid >> 3) * vp_ + (tid & 7) * 8); } while (0)
#define ATT_LSTORE(buf) do { const int b_ = (buf); *(ATT_LAS u32x4*)(lds + b_ * KBUF + (tid / KCH) * KROW + (tid % KCH) * 16) = sk0; \
        if (NKC > 512) { if (tid < NKC - 512) *(ATT_LAS u32x4*)(lds + b_ * KBUF + ((tid + 512) / KCH) * KROW + ((tid + 512) % KCH) * 16) = sk1; } \
        *(ATT_LAS u32x4*)(lds + 2 * KBUF + b_ * VBUF + (tid >> 3) * VROW + (tid & 7) * 16) = sv; } while (0)
    ATT_GLOAD(-1); ATT_LSTORE(0); __syncthreads();
    for (int it = 0; it < nt; ++it) {
        const int buf = it & 1, tile = it == 0 ? -1 : d.t_lo + it - 1; const bool more = it + 1 < nt;
        if (more) ATT_GLOAD(d.t_lo + it);
        const ATT_LAS unsigned char* kb = lds + buf * KBUF + r32 * KROW + hi * 16;
        f32x16 p0, p1;
#pragma unroll
        for (int r = 0; r < 16; ++r) { p0[r] = 0.f; p1[r] = 0.f; }
#pragma unroll
        for (int ds = 0; ds < NDS; ++ds) {
            const bf16x8 k0 = *(const ATT_LAS bf16x8*)(kb + ds * 32), k1 = *(const ATT_LAS bf16x8*)(kb + 32 * KROW + ds * 32);
            p0 = __builtin_amdgcn_mfma_f32_32x32x16_bf16(k0, qr[ds], p0, 0, 0, 0);
            p1 = __builtin_amdgcn_mfma_f32_32x32x16_bf16(k1, qr[ds], p1, 0, 0, 0);
        }
        if (tile < 0) {
#pragma unroll
            for (int r = 0; r < 16; ++r) { p0[r] = -INFINITY; if (r < 8) p1[r] = -INFINITY; }
        } else if (BAND) {
            const int dk = tile * 64 - d.tq;
#pragma unroll
            for (int r = 0; r < 16; ++r) { const int df = dk + crow(r, hi); if (df > 128 || df < -128) p0[r] = -INFINITY; if (df + 32 > 128 || df + 32 < -128) p1[r] = -INFINITY; }
        }
        float rm = fmaxf(p0[0], p1[0]);
#pragma unroll
        for (int r = 1; r < 16; ++r) rm = fmaxf(rm, fmaxf(p0[r], p1[r]));
        rm = swapmax(rm);
        const float mn = fmaxf(mrun, rm), alpha = __builtin_amdgcn_exp2f(mrun - mn); mrun = mn;
        float rsum = 0.f;
#pragma unroll
        for (int r = 0; r < 16; ++r) { p0[r] = __builtin_amdgcn_exp2f(p0[r] - mn); p1[r] = __builtin_amdgcn_exp2f(p1[r] - mn); rsum += p0[r] + p1[r]; }
        lrun = lrun * alpha + rsum;
#pragma unroll
        for (int r = 0; r < 16; ++r) { o0[r] *= alpha; o1[r] *= alpha; }
        u32x4 pw[4];
#pragma unroll
        for (int j = 0; j < 4; ++j) { pw[0][j] = cvtpk(p0[2 * j], p0[2 * j + 1]); pw[1][j] = cvtpk(p0[8 + 2 * j], p0[9 + 2 * j]); pw[2][j] = cvtpk(p1[2 * j], p1[2 * j + 1]); pw[3][j] = cvtpk(p1[8 + 2 * j], p1[9 + 2 * j]); }
        const ATT_LAS unsigned char* vb = lds + 2 * KBUF + buf * VBUF + r32 * VROW + hi * 8;
#pragma unroll
        for (int s = 0; s < 4; ++s) {
            const bf16x8 pb = __builtin_bit_cast(bf16x8, pw[s]);
            { const s16x4 lo = *(const ATT_LAS s16x4*)(vb + s * 32), h4 = *(const ATT_LAS s16x4*)(vb + s * 32 + 16);
              const bf16x8 vf = {lo[0], lo[1], lo[2], lo[3], h4[0], h4[1], h4[2], h4[3]}; o0 = __builtin_amdgcn_mfma_f32_32x32x16_bf16(vf, pb, o0, 0, 0, 0); }
            { const s16x4 lo = *(const ATT_LAS s16x4*)(vb + 32 * VROW + s * 32), h4 = *(const ATT_LAS s16x4*)(vb + 32 * VROW + s * 32 + 16);
              const bf16x8 vf = {lo[0], lo[1], lo[2], lo[3], h4[0], h4[1], h4[2], h4[3]}; o1 = __builtin_amdgcn_mfma_f32_32x32x16_bf16(vf, pb, o1, 0, 0, 0); }
        }
        if (more) ATT_LSTORE(buf ^ 1);
        __syncthreads();
    }
#undef ATT_GLOAD
#undef ATT_LSTORE
    float lt = swapsum(lrun);
    if (BAND) lt += __builtin_amdgcn_exp2f(d.sinkl2 - mrun);
    const float il = 1.0f / lt;
#pragma unroll
    for (int g = 0; g < 4; ++g) {
        u32x2 w0, w1;
        w0.x = cvtpk(o0[4 * g] * il, o0[4 * g + 1] * il); w0.y = cvtpk(o0[4 * g + 2] * il, o0[4 * g + 3] * il);
        w1.x = cvtpk(o1[4 * g] * il, o1[4 * g + 1] * il); w1.y = cvtpk(o1[4 * g + 2] * il, o1[4 * g + 3] * il);
        *(u32x2*)(d.optr + 8 * g + 4 * hi) = w0; *(u32x2*)(d.optr + 32 + 8 * g + 4 * hi) = w1;
    }
}
}

#define LAS __attribute__((address_space(3)))
typedef unsigned short bf16;
typedef float f32x4 __attribute__((ext_vector_type(4)));
typedef unsigned v4u __attribute__((ext_vector_type(4)));
typedef unsigned v2u __attribute__((ext_vector_type(2)));
__device__ __forceinline__ float wave_sum(float v) {
#pragma unroll
    for (int o = 1; o < 64; o <<= 1) v += __shfl_xor(v, o);
    return v;
}
__device__ __forceinline__ unsigned f2bf(float f) { unsigned u = __builtin_bit_cast(unsigned, f); return (u + 0x7fffu + ((u >> 16) & 1u)) >> 16; }
__device__ __forceinline__ unsigned pk2(float lo, float hi) { return f2bf(lo) | (f2bf(hi) << 16); }

template <class KM, class NM>
__device__ __forceinline__ void transpose_item(const float* W, int Nsrc, int Kdst, int Ndst, bf16* WT, const float* gain, LAS float* scr, int item, int lane, KM kmap, NM nmap) {
    const int nblk = Ndst / 32, kb = item / nblk, nb = item % nblk, k0 = 64 * kb, n0 = 32 * nb;
    const int sn = nmap(n0 + (lane & 31));
#pragma unroll 8
    for (int i = 0; i < 32; ++i) { const int kk = 2 * i + (lane >> 5), sk = kmap(k0 + kk);
        float v = 0.f; if (sk >= 0 && sn >= 0) { v = W[(size_t)sk * Nsrc + sn]; if (gain) v *= gain[sk]; }
        scr[kk * 33 + (lane & 31)] = v; }
    asm volatile("s_waitcnt lgkmcnt(0)" ::: "memory");
    const int c = lane & 7;
#pragma unroll
    for (int j = 0; j < 4; ++j) { const int n = (lane >> 3) + 8 * j; const LAS float* s = scr + (8 * c) * 33 + n;
        v4u o; o.x = pk2(s[0 * 33], s[1 * 33]); o.y = pk2(s[2 * 33], s[3 * 33]); o.z = pk2(s[4 * 33], s[5 * 33]); o.w = pk2(s[6 * 33], s[7 * 33]);
        *(v4u*)(WT + (size_t)(n0 + n) * Kdst + k0 + 8 * c) = o; }
    asm volatile("s_waitcnt lgkmcnt(0)" ::: "memory");
}
__device__ __forceinline__ int nmap_win(int n) {
    if (n < 384) return n;
    if (n < 512) { const int j = n - 384, g = j >> 6, c = j & 63, i = c >> 1; return 1184 + g * 64 + ((c & 1) ? i + 32 : i); }
    if (n < 768) return 384 + (n - 512);
    if (n < 1280) { const int j = n - 768, h = j >> 6, c = j & 63, i = c >> 1; return 672 + h * 64 + ((c & 1) ? i + 32 : i); }
    if (n < 1408) return 1312 + (n - 1280);
    if (n < 1440) { const int j = n - 1408, i = j >> 1; return 640 + ((j & 1) ? i + 16 : i); }
    if (n < 1536) return -1;
    if (n < 2560) return 1440 + (n - 1536);
    return 2464 + (n - 2560);
}

__device__ __forceinline__ void row_one(int lane, const float* Frow, const float* brow, const float* gain, float coef, float* orow, bf16* xrow, float* xrow_f32) {
    f32x4 b[4];
#pragma unroll
    for (int j = 0; j < 4; ++j) b[j] = *((const f32x4*)brow + lane + 64 * j);
    if (Frow) {
        f32x4 f[4]; float s = 0.f;
#pragma unroll
        for (int j = 0; j < 4; ++j) { f[j] = *((const f32x4*)Frow + lane + 64 * j); s += (f[j][0] * f[j][0] + f[j][1] * f[j][1]) + (f[j][2] * f[j][2] + f[j][3] * f[j][3]); }
        const float r = rsqrtf(wave_sum(s) * (1.f / DM) + RMS_EPS) * coef;
#pragma unroll
        for (int j = 0; j < 4; ++j) { const f32x4 g = *((const f32x4*)gain + lane + 64 * j); b[j] += f[j] * r * g; }
    }
    if (orow) {
#pragma unroll
        for (int j = 0; j < 4; ++j) *((f32x4*)orow + lane + 64 * j) = b[j];
    }
    if (xrow || xrow_f32) {
        float s = 0.f;
#pragma unroll
        for (int j = 0; j < 4; ++j) s += (b[j][0] * b[j][0] + b[j][1] * b[j][1]) + (b[j][2] * b[j][2] + b[j][3] * b[j][3]);
        const float r = rsqrtf(wave_sum(s) * (1.f / DM) + RMS_EPS);
        if (xrow) {
#pragma unroll
            for (int j = 0; j < 4; ++j) { v2u w; w.x = pk2(b[j][0] * r, b[j][1] * r); w.y = pk2(b[j][2] * r, b[j][3] * r); *((v2u*)xrow + lane + 64 * j) = w; }
        }
        if (xrow_f32) {
#pragma unroll
            for (int j = 0; j < 4; ++j) *((f32x4*)xrow_f32 + lane + 64 * j) = b[j] * r;
        }
    }
}
__device__ __forceinline__ void rowpass(int gw, int ngw, int lane, const float* F, const float* base, const float* gain, float coef, float* out, bf16* xn) {
    for (int m = gw; m < MH; m += ngw)
        row_one(lane, F ? F + (size_t)m * DM : nullptr, base + (size_t)m * DM, gain, coef, out ? out + (size_t)m * DM : nullptr, xn ? xn + (size_t)m * DM : nullptr, nullptr);
}

template <class CM, class AF, class OF>
__device__ __forceinline__ void skinny(const bf16* Bt, int K, int ncols, int gw, int ngw, int lane, CM cmap, AF af, OF of) {
    for (int c = gw; c < ncols; c += ngw) {
        const int n = cmap(c);
        float acc[16];
#pragma unroll
        for (int r = 0; r < 16; ++r) acc[r] = 0.f;
        for (int k = lane; k < K; k += 64) {
            const float b = bf2f(Bt[(size_t)n * K + k]);
#pragma unroll
            for (int r = 0; r < 16; ++r) acc[r] += af(r, k) * b;
        }
#pragma unroll
        for (int r = 0; r < 16; ++r) acc[r] = wave_sum(acc[r]);
        if (lane == 0) {
#pragma unroll
            for (int r = 0; r < 16; ++r) of(r, n, acc[r]);
        }
    }
}

#ifndef DUMP_OFF
#define DUMP_OFF 0
#define DUMP_CNT 0
#endif
#ifndef PH_LIMIT
#define PH_LIMIT 1000
#endif

#ifndef PH_MASK
#define PH_MASK 0xFFFFFFu
#endif
struct Args { const float* in[22]; float* out; unsigned char* ws; int ph_lo, ph_hi; };
typedef const __attribute__((address_space(4))) unsigned char* kargp_t;
__device__ __forceinline__ kargp_t kargp() { kargp_t k = (kargp_t)__builtin_amdgcn_kernarg_segment_ptr(); asm volatile("" : "+s"(k)); return k; }
#define KIN(i) (*(const float* const __attribute__((address_space(4)))*)(kargp() + 8 * (i)))
#define KOUT() (*(float* const __attribute__((address_space(4)))*)(kargp() + 8 * 22))
#define KWS() (*(unsigned char* const __attribute__((address_space(4)))*)(kargp() + 8 * 23))
#define WSP(T, off) ((T*)(KWS() + (off)))

enum { C_P0 = 0, C_M1, C_P1, C_M2, C_P2, C_R2, C_M4, C_P3, C_M5, C_P4A, C_P4B, C_P5, C_P6A, C_P6B, C_P7, C_R7, C_P8, C_P9, C_R9, C_FILL, C_NUM };
constexpr int N_PHASES = 1 + 18 + 14;
__device__ __forceinline__ void prog(int ph, int& code, int& half, bool& nosync) {
    if (ph == 0) { code = C_P0; half = 0; nosync = false; return; }
    if (ph >= 200) { code = C_FILL + 1; half = 0; nosync = false; return; }
    if (ph >= 100) { code = C_FILL; half = ph - 100; nosync = false; return; }
    if (ph <= 18) { code = ph; half = 0; }
    else { const int q = ph - 19; half = 1; code = q == 0 ? C_P1 : q == 1 ? C_P2 : q == 2 ? C_R2 : q == 3 ? C_P3 : C_P4A + (q - 4); }
    nosync = (code == C_M1 || code == C_M2 || code == C_M4 || code == C_M5 || code == C_P4A || code == C_P6A);
}

__global__ void __launch_bounds__(NWAVES * 64, 2) enc_fwd(Args args) {
    extern __shared__ __attribute__((aligned(16))) unsigned char lds_raw[];
    cg::grid_group grid = cg::this_grid();
    LAS unsigned char* lds = (LAS unsigned char*)lds_raw;
    const int ph_hi = args.ph_hi;

    for (int ph = args.ph_lo; ph < ph_hi; ++ph) {
        int code, half; bool nosync; prog(ph, code, half, nosync);
#define IDS() int tid_ = threadIdx.x, G_ = gridDim.x, bx_ = blockIdx.x; asm volatile("" : "+v"(tid_), "+s"(G_), "+s"(bx_)); \
        const int tid = tid_, lane = tid & 63, wave = __builtin_amdgcn_readfirstlane(tid >> 6); \
        const int G = G_, bx = bx_, vcu = (G % 8 == 0) ? (bx % 8) * (G / 8) + bx / 8 : bx; \
        const int gw = vcu * NWAVES + wave, ngw = G * NWAVES; (void)tid; (void)lane; (void)gw; (void)ngw; (void)vcu
#define GIDS() int G_ = gridDim.x, bx_ = blockIdx.x; asm volatile("" : "+s"(G_), "+s"(bx_))
        const int S = half ? 8192 : 2048, logS = half ? 13 : 11, smask = S - 1, rofs = half * MH;
        switch (((PH_MASK >> code) & 1u) ? code : 99) {
        case C_P0: { IDS();
            LAS float* scr = (LAS float*)(lds + wave * 16384);
            auto idk = [](int k) { return k; }; auto idn = [](int n) { return n; };
            auto nm_w1 = [](int n) { const int t = n >> 8, w = n & 255; return w < 128 ? t * 128 + w : DFF + t * 128 + (w - 128); };
            auto nm_uq = [](int n) { const int h = n / 96, c = n % 96; if (c < 64) return h * 96 + c; const int j = c - 64, i = j >> 1; return h * 96 + 64 + ((j & 1) ? i + 16 : i); };
            auto nm_ukv = [](int n) { const int m = n & 511, h = m >> 6, d = m & 63; return h * 128 + (n < 512 ? 0 : 64) + d; };
            auto km_oa = [](int k) { const int h = k / 96, d = k % 96; return d < 64 ? h * 64 + d : -1; };
            constexpr int I1 = 16 * 176, I2 = 44 * 32, I3 = 16 * 112, I4 = 6 * 24, I5 = 4 * 32, I6 = 12 * 32, I7 = 8 * 32, I8 = 16 * 32;
            constexpr int NIT = 2 * I1 + 2 * I2 + I3 + I4 + I5 + I6 + I7 + I8;
            for (int it = gw; it < NIT; it += ngw) {
                int r = it;
                if (r < I1) { transpose_item(KIN(4), 2 * DFF, DM, 2 * DFF, WSP(bf16, WS_W1T), KIN(3), scr, r, lane, idk, nm_w1); continue; } r -= I1;
                if (r < I1) { transpose_item(KIN(19), 2 * DFF, DM, 2 * DFF, WSP(bf16, WS_W1T2), KIN(18), scr, r, lane, idk, nm_w1); continue; } r -= I1;
                if (r < I2) { transpose_item(KIN(5), DM, DFF, DM, WSP(bf16, WS_W2T), nullptr, scr, r, lane, idk, idn); continue; } r -= I2;
                if (r < I2) { transpose_item(KIN(20), DM, DFF, DM, WSP(bf16, WS_W2T2), nullptr, scr, r, lane, idk, idn); continue; } r -= I2;
                if (r < I3) { transpose_item(KIN(8), 3488, DM, N_WIN, WSP(bf16, WS_WINT), KIN(7), scr, r, lane, idk, [](int n) { return nmap_win(n); }); continue; } r -= I3;
                if (r < I4) { transpose_item(KIN(10), 768, 384, 768, WSP(bf16, WS_WUQT), KIN(9), scr, r, lane, idk, nm_uq); continue; } r -= I4;
                if (r < I5) { transpose_item(KIN(12), 1024, 256, 1024, WSP(bf16, WS_WUKVT), KIN(11), scr, r, lane, idk, nm_ukv); continue; } r -= I5;
                if (r < I6) { transpose_item(KIN(14), 1024, 768, 1024, WSP(bf16, WS_WOAT), nullptr, scr, r, lane, km_oa, idn); continue; } r -= I6;
                if (r < I7) { transpose_item(KIN(15), 1024, 512, 1024, WSP(bf16, WS_WOBT), nullptr, scr, r, lane, idk, idn); continue; } r -= I7;
                transpose_item(KIN(16), 1024, 1024, 1024, WSP(bf16, WS_WOUTT), nullptr, scr, r, lane, idk, idn);
            }
            { float* z = WSP(float, WS_SSQQ); for (int i = bx * 512 + tid; i < 2 * 32768; i += G * 512) z[i] = 0.f; }
            { unsigned* z = WSP(unsigned, WS_KMETA); for (int i = bx * 512 + tid; i < (int)((WS_RAWKV - WS_KMETA) / 4); i += G * 512) z[i] = 0u; }
            rowpass(gw, ngw, lane, nullptr, KIN(0), nullptr, 0.f, nullptr, WSP(bf16, WS_XN));
            if (gw < 16) row_one(lane, nullptr, KIN(2) + (size_t)gw * DM, nullptr, 0.f, nullptr, nullptr, WSP(float, WS_XNM) + (size_t)gw * DM);
        } break;
        case C_M1: { IDS();
            const float* XNM = WSP(float, WS_XNM); float* RAW1 = WSP(float, WS_RAW1);
            skinny(WSP(bf16, WS_W1T), DM, 2 * DFF, gw, ngw, lane, [](int c) { return c; }, [=](int r, int k) { return XNM[r * DM + k]; }, [=](int r, int n, float v) { RAW1[r * (2 * DFF) + n] = v; });
        } break;
        case C_P1: { GIDS();
            pg8::Gemm g{WSP(bf16, WS_XN), WSP(bf16, WS_W1T), MH, 2 * DFF, DM}; pg8::StaticOrder So; So.init(MH, 2 * DFF, G_, bx_); pg8::EpiSwiglu E{KWS()};
            pg8::gemm_phase<pg8::EpiSwiglu, pg8::StaticOrder, true, true>(lds, g, So, E);
        } break;
        case C_M2: { IDS();
            const float* RAW1 = WSP(float, WS_RAW1); float* FM = WSP(float, WS_FM);
            skinny(WSP(bf16, WS_W2T), DFF, DM, gw, ngw, lane, [](int c) { return c; },
                [=](int r, int k) { const int t = k >> 7, w = k & 127; const float gg = RAW1[r * (2 * DFF) + t * 256 + w], uu = RAW1[r * (2 * DFF) + t * 256 + 128 + w]; return gg * sigm_f(gg) * uu; },
                [=](int r, int n, float v) { FM[r * DM + n] = v; });
        } break;
        case C_P2: { GIDS();
            pg8::Gemm g{WSP(bf16, R_ACT), WSP(bf16, WS_W2T), MH, DM, DFF}; pg8::StaticOrder So; So.init(MH, DM, G_, bx_); pg8::EpiF32 E{KOUT() + (size_t)rofs * DM, DM};
            pg8::gemm_phase<pg8::EpiF32, pg8::StaticOrder, true, true>(lds, g, So, E);
        } break;
        case C_R2: { IDS();
            float* xres = KOUT() + (size_t)rofs * DM;
            rowpass(gw, ngw, lane, xres, KIN(half), KIN(6), 0.5f, xres, WSP(bf16, WS_XN));
            if (half == 0 && gw < 16) row_one(lane, WSP(float, WS_FM) + (size_t)gw * DM, KIN(2) + (size_t)gw * DM, KIN(6), 0.5f, nullptr, nullptr, WSP(float, WS_H2M) + (size_t)gw * DM);
        } break;
        case C_M4: { IDS();
            const float* H2M = WSP(float, WS_H2M); float* RAWP = WSP(float, WS_RAWP);
            skinny(WSP(bf16, WS_WINT), DM, 544, gw, ngw, lane, [](int c) { return c < 128 ? 384 + c : (c < 384 ? 512 + (c - 128) : (c < 512 ? 1280 + (c - 384) : 1408 + (c - 512))); },
                [=](int r, int k) { return H2M[r * DM + k]; }, [=](int r, int n, float v) { RAWP[r * N_WIN + n] = v; });
        } break;
        case C_P3: { GIDS();
            pg8::Gemm g{WSP(bf16, WS_XN), WSP(bf16, WS_WINT), MH, N_WIN, DM}; pg8::StaticOrder So; So.init(MH, N_WIN, G_, bx_);
            pg8::EpiProj E{KWS(), rofs, smask};
            pg8::gemm_phase<pg8::EpiProj, pg8::StaticOrder, true, true>(lds, g, So, E);
        } break;
        case C_M5: { IDS();
            const float* RAWP = WSP(float, WS_RAWP);
            bf16* KMETA = WSP(bf16, WS_KMETA); bf16* VMETA = WSP(bf16, WS_VMETA);
            if (gw < 1024) {
                const bf16* WUKVT = WSP(bf16, WS_WUKVT);
                const int n = gw; float acc[16], ssr[16];
#pragma unroll
                for (int r = 0; r < 16; ++r) { acc[r] = 0.f; ssr[r] = 0.f; }
                for (int k = lane; k < 256; k += 64) { const float b = bf2f(WUKVT[(size_t)n * 256 + k]);
#pragma unroll
                    for (int r = 0; r < 16; ++r) { const float v = RAWP[r * N_WIN + 512 + k]; acc[r] += v * b; ssr[r] += v * v; } }
#pragma unroll
                for (int r = 0; r < 16; ++r) acc[r] = wave_sum(acc[r]) * rsqrtf(wave_sum(ssr[r]) * (1.f / 256.f) + RMS_EPS);
                if (lane == 0) { const int m = n & 511, h = m >> 6, d = m & 63;
#pragma unroll
                    for (int r = 0; r < 16; ++r) { if (n < 512) KMETA[(h * 64 + 48 + r) * 96 + d] = (bf16)f2bf(acc[r]); else VMETA[(h * 64 + d) * 64 + 48 + r] = (bf16)f2bf(acc[r]); } }
            }
            if (bx == 0) {
                bf16* KSMETA = WSP(bf16, WS_KSMETA); bf16* VSMETA = WSP(bf16, WS_VSMETA);
                for (int i = tid; i < 16 * 16; i += 512) {
                    const int r = i >> 4, p = i & 15; float c, s; rope_cs(r, __builtin_amdgcn_exp2f(-(float)p * (ROPE_L2T / 16.f)), c, s);
                    const float x1 = RAWP[r * N_WIN + 1408 + 2 * p], x2 = RAWP[r * N_WIN + 1408 + 2 * p + 1]; const bf16 o1 = (bf16)f2bf(x1 * c - x2 * s), o2 = (bf16)f2bf(x2 * c + x1 * s);
                    for (int h = 0; h < 8; ++h) { KMETA[(h * 64 + 48 + r) * 96 + 64 + 2 * p] = o1; KMETA[(h * 64 + 48 + r) * 96 + 64 + 2 * p + 1] = o2; } }
                for (int i = tid; i < 16 * 64; i += 512) {
                    const int r = i >> 6, gp = i & 63, g2 = gp >> 5, p = gp & 31; float c, s; rope_cs(r, __builtin_amdgcn_exp2f(-(float)p * (ROPE_L2T / 32.f)), c, s);
                    const float x1 = RAWP[r * N_WIN + 384 + g2 * 64 + 2 * p], x2 = RAWP[r * N_WIN + 384 + g2 * 64 + 2 * p + 1];
                    KSMETA[(g2 * 64 + 48 + r) * 64 + 2 * p] = (bf16)f2bf(x1 * c - x2 * s); KSMETA[(g2 * 64 + 48 + r) * 64 + 2 * p + 1] = (bf16)f2bf(x2 * c + x1 * s); }
                for (int i = tid; i < 16 * 128; i += 512) { const int r = i >> 7, gd = i & 127; VSMETA[gd * 64 + 48 + r] = (bf16)f2bf(RAWP[r * N_WIN + 1280 + gd]); }
            }
        } break;
        case C_P4A: { GIDS();
            pg8::Gemm g{WSP(bf16, R_CQ), WSP(bf16, WS_WUQT), MH, 768, 384}; pg8::StaticOrder So; So.init(MH, 768, G_, bx_); pg8::EpiQ E{KWS(), rofs, smask};
            pg8::gemm_phase<pg8::EpiQ, pg8::StaticOrder, true, true>(lds, g, So, E);
        } break;
        case C_P4B: { GIDS();
            pg8::Gemm g{WSP(bf16, R_CKV), WSP(bf16, WS_WUKVT), MH, 1024, 256}; pg8::StaticOrder So; So.init(MH, 1024, G_, bx_); pg8::EpiKV E{KWS(), rofs};
            pg8::gemm_phase<pg8::EpiKV, pg8::StaticOrder, true, true>(lds, g, So, E);
        } break;
        case C_P5: { IDS();
            for (int L = vcu; L < 512; L += G) {
                const int round = L >> 8, v = L & 255; int pair, qblk;
                if (half == 0) { pair = 8 * (v >> 5) + 4 * round + ((v & 31) >> 3); qblk = v & 7; } else { pair = 2 * (v >> 5) + round; qblk = v & 31; }
                const int seq = pair >> 3, h = pair & 7, row = seq * S + qblk * 256 + wave * 32 + (lane & 31);
                bf16* QA = WSP(bf16, R_QA);
                att::UnitDesc d; d.qptr = QA + (size_t)row * 768 + h * 96; d.optr = QA + (size_t)row * 768 + h * 96;
                d.kmeta = WSP(bf16, WS_KMETA) + h * 64 * 96; d.vmeta = WSP(bf16, WS_VMETA) + h * 64 * 64; d.kmain = WSP(bf16, R_KF) + ((size_t)h * MH + (size_t)seq * S) * 96; d.vmain = WSP(bf16, R_VT) + (size_t)h * 64 * MH + (size_t)seq * S;
                d.t_lo = 0; d.t_hi = S / 64; d.tq = 0; d.sinkl2 = 0.f;
                att::attn_unit<96, false>(lds, d);
            }
            for (int L = vcu; L < 512; L += G) {
                const int g2 = L >> 8, tt = L & 255, hrow0 = tt * 64, seq = hrow0 >> logS, t0 = hrow0 & smask;
                const int hq = g2 * 4 + (wave >> 1), qi = (wave & 1) * 32 + (lane & 31), row = hrow0 + qi;
                bf16* QS = WSP(bf16, R_QS);
                att::UnitDesc d; d.qptr = QS + (size_t)row * 512 + hq * 64; d.optr = QS + (size_t)row * 512 + hq * 64;
                d.kmeta = WSP(bf16, WS_KSMETA) + g2 * 64 * 64; d.vmeta = WSP(bf16, WS_VSMETA) + g2 * 64 * 64; d.kmain = WSP(bf16, R_KS) + ((size_t)g2 * MH + (size_t)seq * S) * 64; d.vmain = WSP(bf16, R_VTS) + (size_t)g2 * 64 * MH + (size_t)seq * S;
                const int tb = t0 >> 6; d.t_lo = tb - 2 < 0 ? 0 : tb - 2; d.t_hi = tb + 3 > S / 64 ? S / 64 : tb + 3; d.tq = t0 + qi; d.sinkl2 = KIN(13)[hq] * LOG2E_F;
                att::attn_unit<64, true>(lds, d);
            }
        } break;
        case C_P6A: { GIDS();
            pg8::Gemm g{WSP(bf16, R_QA), WSP(bf16, WS_WOAT), MH, DM, 768}; pg8::StaticOrder So; So.init(MH, DM, G_, bx_); pg8::EpiGate<false> E{KWS()};
            pg8::gemm_phase<pg8::EpiGate<false>, pg8::StaticOrder, true, true>(lds, g, So, E);
        } break;
        case C_P6B: { GIDS();
            pg8::Gemm g{WSP(bf16, R_QS), WSP(bf16, WS_WOBT), MH, DM, 512}; pg8::StaticOrder So; So.init(MH, DM, G_, bx_); pg8::EpiGate<true> E{KWS()};
            pg8::gemm_phase<pg8::EpiGate<true>, pg8::StaticOrder, true, true>(lds, g, So, E);
        } break;
        case C_P7: { GIDS();
            pg8::Gemm g{WSP(bf16, WS_XN), WSP(bf16, WS_WOUTT), MH, DM, DM}; pg8::StaticOrder So; So.init(MH, DM, G_, bx_); pg8::EpiF32 E{WSP(float, R_Y), DM};
            pg8::gemm_phase<pg8::EpiF32, pg8::StaticOrder, true, true>(lds, g, So, E);
        } break;
        case C_R7: { IDS(); float* xres = KOUT() + (size_t)rofs * DM; rowpass(gw, ngw, lane, WSP(float, R_Y), xres, KIN(17), 1.0f, xres, WSP(bf16, WS_XN)); } break;
        case C_P8: { GIDS();
            pg8::Gemm g{WSP(bf16, WS_XN), WSP(bf16, WS_W1T2), MH, 2 * DFF, DM}; pg8::StaticOrder So; So.init(MH, 2 * DFF, G_, bx_); pg8::EpiSwiglu E{KWS()};
            pg8::gemm_phase<pg8::EpiSwiglu, pg8::StaticOrder, true, true>(lds, g, So, E);
        } break;
        case C_P9: { GIDS();
            pg8::Gemm g{WSP(bf16, R_ACT), WSP(bf16, WS_W2T2), MH, DM, DFF}; pg8::StaticOrder So; So.init(MH, DM, G_, bx_); pg8::EpiF32 E{WSP(float, R_F2), DM};
            pg8::gemm_phase<pg8::EpiF32, pg8::StaticOrder, true, true>(lds, g, So, E);
        } break;
        case C_R9: { IDS();
            float* xres = KOUT() + (size_t)rofs * DM;
            rowpass(gw, ngw, lane, WSP(float, R_F2), xres, KIN(21), 0.5f, xres, nullptr);
            if (half == 0) rowpass(gw, ngw, lane, nullptr, KIN(1), nullptr, 0.f, nullptr, WSP(bf16, WS_XN));
        } break;
        case C_FILL: { IDS(); rowpass(gw, ngw, lane, nullptr, KIN(half), nullptr, 0.f, KOUT() + (size_t)rofs * DM, nullptr); } break;
        case C_FILL + 1: { IDS();
            const bf16* src = WSP(bf16, (size_t)DUMP_OFF); float* o = KOUT();
            for (size_t i = (size_t)bx * 512 + tid; i < (size_t)2 * MH * DM; i += (size_t)G * 512) o[i] = i < (size_t)DUMP_CNT ? bf2f(src[i]) : 0.f;
        } break;
        default: break;
        }
        if (ph + 1 < ph_hi) { if (nosync) { asm volatile("s_waitcnt vmcnt(0) lgkmcnt(0)" ::: "memory"); __syncthreads(); } else grid.sync(); }
    }
}

#ifndef MK_PER_PHASE
#define MK_PER_PHASE 1
#endif
extern "C" void kernel_launch(void* const* d_in, const int* in_sizes, int n_in, void* d_out, int out_size, void* d_ws, size_t ws_size, hipStream_t stream) {
    static int grid = 0;
    if (grid == 0) {
        if (n_in != 22 || ws_size < WS_END) { fprintf(stderr, "kernel_launch: unexpected problem (n_in %d, ws %zu)\n", n_in, ws_size); grid = -1; return; }
        int dev = 0, cus = 0, per_cu = 0;
        (void)hipGetDevice(&dev); (void)hipDeviceGetAttribute(&cus, hipDeviceAttributeMultiprocessorCount, dev);
        if (hipFuncSetAttribute((const void*)enc_fwd, hipFuncAttributeMaxDynamicSharedMemorySize, LDS_BYTES) != hipSuccess) { fprintf(stderr, "kernel_launch: hipFuncSetAttribute failed\n"); grid = -1; return; }
        if (hipOccupancyMaxActiveBlocksPerMultiprocessor(&per_cu, (const void*)enc_fwd, NWAVES * 64, LDS_BYTES) != hipSuccess || per_cu < 1) { fprintf(stderr, "kernel_launch: occupancy query failed (%d)\n", per_cu); (void)hipGetLastError(); per_cu = 1; }
        grid = cus;
    }
    if (grid < 0) return;
    Args a{};
    for (int i = 0; i < 22; ++i) a.in[i] = (const float*)d_in[i];
    a.out = (float*)d_out; a.ws = (unsigned char*)d_ws;
#if MK_PER_PHASE
    for (int p = 0; p < (PH_LIMIT < N_PHASES ? PH_LIMIT : N_PHASES); ++p) { a.ph_lo = p; a.ph_hi = p + 1; hipLaunchKernelGGL(enc_fwd, dim3(grid), dim3(NWAVES * 64), LDS_BYTES, stream, a); }
    if (DUMP_CNT > 0) { a.ph_lo = 200; a.ph_hi = 201; hipLaunchKernelGGL(enc_fwd, dim3(grid), dim3(NWAVES * 64), LDS_BYTES, stream, a); return; }
    if (PH_LIMIT < 6) { a.ph_lo = 100; a.ph_hi = 101; hipLaunchKernelGGL(enc_fwd, dim3(grid), dim3(NWAVES * 64), LDS_BYTES, stream, a); }
    if (PH_LIMIT < 22) { a.ph_lo = 101; a.ph_hi = 102; hipLaunchKernelGGL(enc_fwd, dim3(grid), dim3(NWAVES * 64), LDS_BYTES, stream, a); }
#else
    a.ph_lo = 0; a.ph_hi = N_PHASES;
    void* kargs[] = {&a};
    hipError_t e = hipLaunchCooperativeKernel((const void*)enc_fwd, dim3(grid), dim3(NWAVES * 64), kargs, LDS_BYTES, stream);
    if (e != hipSuccess) fprintf(stderr, "kernel_launch: cooperative launch failed: %s (grid %d)\n", hipGetErrorString(e), grid);
#endif
}
```

```cpp
#include <hip/hip_runtime.h>
#include <hip/hip_cooperative_groups.h>
#include <cstdint>
#include <cstdio>
namespace cg = cooperative_groups;

constexpr int DM = 1024, DFF = 2816, MH = 16384;
constexpr float RMS_EPS = 1e-6f;
constexpr float LOG2E_F = 1.4426950408889634f;
constexpr float SC_A = 0.10206207261596577f * 1.4426950408889634f;
constexpr float SC_B = 0.125f * 1.4426950408889634f;
constexpr float ROPE_L2T = 13.287712379549449f;

__device__ __forceinline__ void rope_cs(int pos, float inv, float& c, float& s) {
    const double rev = (double)((float)pos * inv) * 0.15915494309189535;
    const float f = (float)(rev - __builtin_rint(rev));
    s = __builtin_amdgcn_sinf(f); c = __builtin_amdgcn_cosf(f);
}
__device__ __forceinline__ float sigm_f(float g) { return __builtin_amdgcn_rcpf(1.f + __builtin_amdgcn_exp2f(-g * LOG2E_F)); }
__device__ __forceinline__ float bf2f(unsigned short b) { return __uint_as_float(((unsigned)b) << 16); }

constexpr int NWAVES = 8, LDS_BYTES = 147456;
constexpr size_t MiB = 1u << 20, KiB = 1u << 10;
constexpr size_t WS_SSQQ = 0, WS_SSQKV = 128 * KiB, WS_XNM = 256 * KiB, WS_FM = 320 * KiB, WS_H2M = 384 * KiB, WS_RAWP = 448 * KiB, WS_RAW1 = 704 * KiB,
                 WS_KMETA = 1088 * KiB, WS_VMETA = 1184 * KiB, WS_KSMETA = 1248 * KiB, WS_VSMETA = 1264 * KiB, WS_RAWKV = 1280 * KiB  ;
constexpr size_t WS_W1T = 2 * MiB, WS_W2T = 13 * MiB, WS_W1T2 = 18 * MiB + 512 * KiB, WS_W2T2 = 29 * MiB + 512 * KiB, WS_WINT = 35 * MiB, WS_WUQT = 42 * MiB, WS_WUKVT = 42 * MiB + 768 * KiB,
                 WS_WOAT = 43 * MiB + 512 * KiB, WS_WOBT = 45 * MiB, WS_WOUTT = 46 * MiB;
constexpr size_t WS_XN = 48 * MiB, WS_R = 80 * MiB, WS_END = 254 * MiB;
constexpr size_t R_ACT = WS_R, R_F2 = WS_R + 88 * MiB;
constexpr size_t R_GA = WS_R, R_GB = WS_R + 32 * MiB, R_QS = WS_R + 64 * MiB, R_QA = WS_R + 80 * MiB, R_KF = WS_R + 104 * MiB, R_VT = WS_R + 128 * MiB, R_KS = WS_R + 144 * MiB, R_VTS = WS_R + 148 * MiB,
                 R_CQ = WS_R + 152 * MiB, R_CKV = WS_R + 164 * MiB, R_T = WS_R + 104 * MiB, R_Y = WS_R;
constexpr int N_WIN = 3584;

namespace pg8 {
#define PG8_LAS __attribute__((address_space(3)))
typedef unsigned short bf16_t;
typedef short bf16x8 __attribute__((ext_vector_type(8)));
typedef float f32x4 __attribute__((ext_vector_type(4)));
typedef unsigned u32x4 __attribute__((ext_vector_type(4)));
constexpr int BM = 256, BK = 64, HALF = 128, HTB = HALF * BK * 2  , STAGE_BYTES = 8 * HTB, NXCD = 8, WGM = 8;

__host__ __device__ __forceinline__ int lds_byte(int r, int c) { const int st = (r >> 4) * 2 + (c >> 5), rr = r & 15, cc = c & 31, ob = rr * 64 + cc * 2; return st * 1024 + (ob ^ (((ob >> 9) & 1) << 5)); }
__host__ __device__ __forceinline__ void stage_rc(int b, int& R, int& C) { const int st = b / 1024, sb = b % 1024, swz = sb ^ (((sb >> 9) & 1) << 5); R = (st >> 1) * 16 + swz / 64; C = (st & 1) * 32 + (swz % 64) / 2; }
__host__ __device__ __forceinline__ int perm32(int rho) { const int n = rho >> 4, i = rho & 15; return 8 * (i >> 2) + 4 * n + (i & 3); }

struct Unit { int pm, pn; };
struct Gemm { const bf16_t* A; const bf16_t* Bt; int M, N, K; };

struct StaticOrder {
    int nM, nN, nwg, G, c;
    __host__ __device__ void init(int M, int N, int G_, int c_) { nM = M / BM; nN = N / BM; nwg = nM * nN; G = G_; c = c_; }
    __host__ __device__ bool next(int i, Unit& u) const {
        const long L = (long)i * G + c; if (L >= nwg) return false;
        int wgid = (int)L; { const int q = nwg / NXCD, r = nwg % NXCD, xcd = wgid % NXCD, off = wgid / NXCD; wgid = (xcd < r ? xcd * (q + 1) : r * (q + 1) + (xcd - r) * q) + off; }
        const int nig = WGM * nN, gid = wgid / nig, fm = gid * WGM, gsz = (nM - fm) < WGM ? (nM - fm) : WGM;
        u.pm = fm + ((wgid % nig) % gsz); u.pn = (wgid % nig) / gsz; return true;
    }
    __device__ __forceinline__ void a_ready(const Unit&) const {}
    __device__ __forceinline__ void done(const Unit&) const {}
};

typedef float f32x2_c __attribute__((ext_vector_type(2))); typedef __bf16 bf16x2_c __attribute__((ext_vector_type(2)));
__device__ __forceinline__ unsigned cvt_pk_bf16(float lo, float hi) { f32x2_c v = {lo, hi}; bf16x2_c b = __builtin_convertvector(v, bf16x2_c); return __builtin_bit_cast(unsigned, b); }
typedef float f32x2 __attribute__((ext_vector_type(2)));
typedef unsigned u32x2 __attribute__((ext_vector_type(2)));
__device__ __forceinline__ u32x4 pack8(const f32x4 a, const f32x4 b) { u32x4 w; w.x = cvt_pk_bf16(a[0], a[1]); w.y = cvt_pk_bf16(a[2], a[3]); w.z = cvt_pk_bf16(b[0], b[1]); w.w = cvt_pk_bf16(b[2], b[3]); return w; }
__device__ __forceinline__ void unpack8(const u32x4 w, f32x4& a, f32x4& b) {
    a[0] = __uint_as_float(w.x << 16); a[1] = __uint_as_float(w.x & 0xffff0000u); a[2] = __uint_as_float(w.y << 16); a[3] = __uint_as_float(w.y & 0xffff0000u);
    b[0] = __uint_as_float(w.z << 16); b[1] = __uint_as_float(w.z & 0xffff0000u); b[2] = __uint_as_float(w.w << 16); b[3] = __uint_as_float(w.w & 0xffff0000u); }
__device__ __forceinline__ void rope8(f32x4& a, f32x4& b, int pos, const float (&inv)[4]) {
    float c, s, x1, x2;
    rope_cs(pos, inv[0], c, s); x1 = a[0]; x2 = a[1]; a[0] = x1 * c - x2 * s; a[1] = x2 * c + x1 * s;
    rope_cs(pos, inv[1], c, s); x1 = a[2]; x2 = a[3]; a[2] = x1 * c - x2 * s; a[3] = x2 * c + x1 * s;
    rope_cs(pos, inv[2], c, s); x1 = b[0]; x2 = b[1]; b[0] = x1 * c - x2 * s; b[1] = x2 * c + x1 * s;
    rope_cs(pos, inv[3], c, s); x1 = b[2]; x2 = b[3]; b[2] = x1 * c - x2 * s; b[3] = x2 * c + x1 * s;
}

struct EpiSwiglu {
    static constexpr bool PERM = true, AFTER_DRAIN = false;
    unsigned char* ws;
    __device__ __forceinline__ void operator()(const f32x4 (&acc)[2][2][4][2], const Unit& u, int wr, int wc_, int fr_, int fq_) const {
        int wc = wc_, fr = fr_, fq = fq_; asm volatile("" : "+s"(wc), "+v"(fr), "+v"(fq));
        bf16_t* O = (bf16_t*)(ws + R_ACT);
        const int col = u.pn * 128 + wc * 32 + fq * 8;
#pragma unroll
        for (int ai = 0; ai < 2; ++ai)
#pragma unroll
            for (int m = 0; m < 4; ++m) {
                const int row = u.pm * BM + ai * HALF + wr * 64 + m * 16 + fr;
                f32x4 o0, o1;
#pragma unroll
                for (int j = 0; j < 4; ++j) { o0[j] = acc[ai][0][m][0][j] * sigm_f(acc[ai][0][m][0][j]) * acc[ai][1][m][0][j]; o1[j] = acc[ai][0][m][1][j] * sigm_f(acc[ai][0][m][1][j]) * acc[ai][1][m][1][j]; }
                *(u32x4*)(O + (size_t)row * DFF + col) = pack8(o0, o1);
            }
    }
};
struct EpiF32 {
    static constexpr bool PERM = true, AFTER_DRAIN = false;
    float* O; int ldc;
    __device__ __forceinline__ void operator()(const f32x4 (&acc)[2][2][4][2], const Unit& u, int wr, int wc_, int fr_, int fq_) const {
        int wc = wc_, fr = fr_, fq = fq_; asm volatile("" : "+s"(wc), "+v"(fr), "+v"(fq));
#pragma unroll
        for (int ai = 0; ai < 2; ++ai)
#pragma unroll
            for (int m = 0; m < 4; ++m) {
                float* rp = O + (size_t)(u.pm * BM + ai * HALF + wr * 64 + m * 16 + fr) * ldc + u.pn * BM + wc * 32 + fq * 8;
#pragma unroll
                for (int bj = 0; bj < 2; ++bj) { *(f32x4*)(rp + bj * HALF) = acc[ai][bj][m][0]; *(f32x4*)(rp + bj * HALF + 4) = acc[ai][bj][m][1]; }
            }
    }
};
struct EpiProj {
    static constexpr bool PERM = true, AFTER_DRAIN = false;
    unsigned char* ws; int rofs, smask;
    __device__ __forceinline__ void operator()(const f32x4 (&acc)[2][2][4][2], const Unit& u, int wr, int wc_, int fr_, int fq_) const {
        int wc = wc_, fr = fr_, fq = fq_; asm volatile("" : "+s"(wc), "+v"(fr), "+v"(fq));
        bf16_t *CQ = (bf16_t*)(ws + R_CQ), *CKV = (bf16_t*)(ws + R_CKV), *QS = (bf16_t*)(ws + R_QS), *GA = (bf16_t*)(ws + R_GA), *GB = (bf16_t*)(ws + R_GB), *Kf = (bf16_t*)(ws + R_KF), *Ks = (bf16_t*)(ws + R_KS), *Vts = (bf16_t*)(ws + R_VTS);
        float *ssq_q = (float*)(ws + WS_SSQQ) + rofs, *ssq_kv = (float*)(ws + WS_SSQKV) + rofs;
        const int pn = u.pn, rbase = u.pm * BM + wr * 64 + fr, cl = wc * 32 + fq * 8;
        if (pn <= 2) {
            bf16_t* dst = (pn == 2) ? CKV : CQ; const int ld = (pn == 2) ? 256 : 384, cbase = (pn == 1) ? 256 : 0; float* ssq = (pn == 2) ? ssq_kv : ssq_q;
#pragma unroll
            for (int ai = 0; ai < 2; ++ai)
#pragma unroll
                for (int m = 0; m < 4; ++m) {
                    const int row = rbase + ai * HALF + m * 16; float s = 0.f;
#pragma unroll
                    for (int bj = 0; bj < 2; ++bj) if (bj == 0 || pn != 1) {
                        const f32x4 a = acc[ai][bj][m][0], b = acc[ai][bj][m][1];
                        s += (a[0] * a[0] + a[1] * a[1]) + (a[2] * a[2] + a[3] * a[3]) + (b[0] * b[0] + b[1] * b[1]) + (b[2] * b[2] + b[3] * b[3]);
                        *(u32x4*)(dst + (size_t)row * ld + cbase + bj * HALF + cl) = pack8(a, b);
                    }
                    s += __shfl_xor(s, 16); s += __shfl_xor(s, 32);
                    if (fq == 0) atomicAdd(ssq + row, s);
                }
            if (pn == 1) {
                const int g = wc >> 1, c = (wc & 1) * 32 + fq * 8; float inv[4];
#pragma unroll
                for (int j = 0; j < 4; ++j) inv[j] = __builtin_amdgcn_exp2f(-(float)(c / 2 + j) * (ROPE_L2T / 32.f));
#pragma unroll
                for (int ai = 0; ai < 2; ++ai)
#pragma unroll
                    for (int m = 0; m < 4; ++m) {
                        const int row = rbase + ai * HALF + m * 16; f32x4 a = acc[ai][1][m][0], b = acc[ai][1][m][1];
                        rope8(a, b, 16 + (row & smask), inv);
                        *(u32x4*)(Ks + ((size_t)g * MH + row) * 64 + c) = pack8(a, b);
                    }
            }
        } else if (pn <= 4) {
            const int c = (wc & 1) * 32 + fq * 8; float inv[4];
#pragma unroll
            for (int j = 0; j < 4; ++j) inv[j] = __builtin_amdgcn_exp2f(-(float)(c / 2 + j) * (ROPE_L2T / 32.f));
#pragma unroll
            for (int ai = 0; ai < 2; ++ai)
#pragma unroll
                for (int m = 0; m < 4; ++m) {
                    const int row = rbase + ai * HALF + m * 16;
#pragma unroll
                    for (int bj = 0; bj < 2; ++bj) {
                        f32x4 a = acc[ai][bj][m][0], b = acc[ai][bj][m][1];
                        rope8(a, b, 16 + (row & smask), inv);
                        *(u32x4*)(QS + (size_t)row * 512 + (pn - 3) * 256 + bj * HALF + cl) = pack8(a * SC_B, b * SC_B);
                    }
                }
        } else if (pn == 5) {
            {
                const int g = wc >> 1, d0 = (wc & 1) * 32 + fq * 8;
#pragma unroll
                for (int ai = 0; ai < 2; ++ai)
#pragma unroll
                    for (int m = 0; m < 4; ++m) {
                        const int row = rbase + ai * HALF + m * 16; const u32x4 w = pack8(acc[ai][0][m][0], acc[ai][0][m][1]);
                        bf16_t* vp = Vts + (size_t)(g * 64 + d0) * MH + row;
                        vp[0] = (bf16_t)(w.x & 0xffffu); vp[MH] = (bf16_t)(w.x >> 16); vp[2 * (size_t)MH] = (bf16_t)(w.y & 0xffffu); vp[3 * (size_t)MH] = (bf16_t)(w.y >> 16);
                        vp[4 * (size_t)MH] = (bf16_t)(w.z & 0xffffu); vp[5 * (size_t)MH] = (bf16_t)(w.z >> 16); vp[6 * (size_t)MH] = (bf16_t)(w.w & 0xffffu); vp[7 * (size_t)MH] = (bf16_t)(w.w >> 16);
                    }
            }
            if (wc == 0) {
                float inv[4];
#pragma unroll
                for (int j = 0; j < 4; ++j) inv[j] = __builtin_amdgcn_exp2f(-(float)(fq * 4 + j) * (ROPE_L2T / 16.f));
#pragma unroll
                for (int ai = 0; ai < 2; ++ai)
#pragma unroll
                    for (int m = 0; m < 4; ++m) {
                        const int row = rbase + ai * HALF + m * 16; f32x4 a = acc[ai][1][m][0], b = acc[ai][1][m][1];
                        rope8(a, b, 16 + (row & smask), inv); const u32x4 w = pack8(a, b);
#pragma unroll
                        for (int h = 0; h < 8; ++h) *(u32x4*)(Kf + ((size_t)h * MH + row) * 96 + 64 + fq * 8) = w;
                    }
            }
        } else {
            bf16_t* dst = (pn < 10) ? GA : GB; const int cb = ((pn < 10) ? (pn - 6) : (pn - 10)) * 256;
#pragma unroll
            for (int ai = 0; ai < 2; ++ai)
#pragma unroll
                for (int m = 0; m < 4; ++m) {
                    const int row = rbase + ai * HALF + m * 16;
#pragma unroll
                    for (int bj = 0; bj < 2; ++bj) {
                        f32x4 a = acc[ai][bj][m][0], b = acc[ai][bj][m][1];
#pragma unroll
                        for (int j = 0; j < 4; ++j) { a[j] = sigm_f(a[j]); b[j] = sigm_f(b[j]); }
                        *(u32x4*)(dst + (size_t)row * DM + cb + bj * HALF + cl) = pack8(a, b);
                    }
                }
        }
    }
};
struct EpiQ {
    static constexpr bool PERM = true, AFTER_DRAIN = false;
    unsigned char* ws; int rofs, smask;
    __device__ __forceinline__ void operator()(const f32x4 (&acc)[2][2][4][2], const Unit& u, int wr, int wc_, int fr_, int fq_) const {
        int wc = wc_, fr = fr_, fq = fq_; asm volatile("" : "+s"(wc), "+v"(fr), "+v"(fq));
        bf16_t* QA = (bf16_t*)(ws + R_QA); const float* ssq_q = (const float*)(ws + WS_SSQQ) + rofs;
        const int rbase = u.pm * BM + wr * 64 + fr;
        float rs[2][4];
#pragma unroll
        for (int ai = 0; ai < 2; ++ai)
#pragma unroll
            for (int m = 0; m < 4; ++m) rs[ai][m] = rsqrtf(ssq_q[rbase + ai * HALF + m * 16] * (1.f / 384.f) + RMS_EPS) * SC_A;
#pragma unroll
        for (int bj = 0; bj < 2; ++bj) {
            const int col = u.pn * BM + bj * HALF + wc * 32 + fq * 8, cih = col % 96; const bool isr = cih >= 64; float inv[4];
#pragma unroll
            for (int j = 0; j < 4; ++j) inv[j] = __builtin_amdgcn_exp2f(-(float)((cih - 64) / 2 + j) * (ROPE_L2T / 16.f));
#pragma unroll
            for (int ai = 0; ai < 2; ++ai)
#pragma unroll
                for (int m = 0; m < 4; ++m) {
                    const int row = rbase + ai * HALF + m * 16; f32x4 a = acc[ai][bj][m][0] * rs[ai][m], b = acc[ai][bj][m][1] * rs[ai][m];
                    if (isr) rope8(a, b, 16 + (row & smask), inv);
                    *(u32x4*)(QA + (size_t)row * 768 + col) = pack8(a, b);
                }
        }
    }
};
struct EpiKV {
    static constexpr bool PERM = true, AFTER_DRAIN = false;
    unsigned char* ws; int rofs;
    __device__ __forceinline__ void operator()(const f32x4 (&acc)[2][2][4][2], const Unit& u, int wr, int wc_, int fr_, int fq_) const {
        int wc = wc_, fr = fr_, fq = fq_; asm volatile("" : "+s"(wc), "+v"(fr), "+v"(fq));
        bf16_t *Kf = (bf16_t*)(ws + R_KF), *Vt = (bf16_t*)(ws + R_VT); const float* ssq_kv = (const float*)(ws + WS_SSQKV) + rofs;
        const int rbase = u.pm * BM + wr * 64 + fr;
#pragma unroll
        for (int ai = 0; ai < 2; ++ai)
#pragma unroll
            for (int m = 0; m < 4; ++m) {
                const int row = rbase + ai * HALF + m * 16; const float rs = rsqrtf(ssq_kv[row] * (1.f / 256.f) + RMS_EPS);
#pragma unroll
                for (int bj = 0; bj < 2; ++bj) {
                    const int col = (u.pn & 1) * BM + bj * HALF + wc * 32 + fq * 8, h = col >> 6, d0 = col & 63;
                    const u32x4 w = pack8(acc[ai][bj][m][0] * rs, acc[ai][bj][m][1] * rs);
                    if (u.pn < 2) { *(u32x4*)(Kf + ((size_t)h * MH + row) * 96 + d0) = w; }
                    else { bf16_t* vp = Vt + (size_t)(h * 64 + d0) * MH + row;
                        vp[0] = (bf16_t)(w.x & 0xffffu); vp[MH] = (bf16_t)(w.x >> 16); vp[2 * (size_t)MH] = (bf16_t)(w.y & 0xffffu); vp[3 * (size_t)MH] = (bf16_t)(w.y >> 16);
                        vp[4 * (size_t)MH] = (bf16_t)(w.z & 0xffffu); vp[5 * (size_t)MH] = (bf16_t)(w.z >> 16); vp[6 * (size_t)MH] = (bf16_t)(w.w & 0xffffu); vp[7 * (size_t)MH] = (bf16_t)(w.w >> 16); }
                }
            }
    }
};
template <bool SECOND> struct EpiGate {
    static constexpr bool PERM = true, AFTER_DRAIN = false;
    unsigned char* ws;
    __device__ __forceinline__ void operator()(const f32x4 (&acc)[2][2][4][2], const Unit& u, int wr, int wc_, int fr_, int fq_) const {
        int wc = wc_, fr = fr_, fq = fq_; asm volatile("" : "+s"(wc), "+v"(fr), "+v"(fq));
        const bf16_t* G = (const bf16_t*)(ws + (SECOND ? R_GB : R_GA)); bf16_t* T = (bf16_t*)(ws + R_T); bf16_t* O = (bf16_t*)(ws + WS_XN);
#pragma unroll
        for (int ai = 0; ai < 2; ++ai)
#pragma unroll
            for (int m = 0; m < 4; ++m)
#pragma unroll
                for (int bj = 0; bj < 2; ++bj) {
                    const size_t off = (size_t)(u.pm * BM + ai * HALF + wr * 64 + m * 16 + fr) * DM + u.pn * BM + bj * HALF + wc * 32 + fq * 8;
                    f32x4 ga, gb; unpack8(*(const u32x4*)(G + off), ga, gb);
                    f32x4 a = acc[ai][bj][m][0] * ga, b = acc[ai][bj][m][1] * gb;
                    if (SECOND) { f32x4 ta, tb; unpack8(*(const u32x4*)(T + off), ta, tb); a += ta; b += tb; *(u32x4*)(O + off) = pack8(a, b); }
                    else *(u32x4*)(T + off) = pack8(a, b);
                }
    }
};
template <class Epi, class Sched, bool ALIGN_EPI = false, bool SP2 = false>
__device__ __forceinline__ void gemm_phase(PG8_LAS unsigned char* lds, const Gemm g, const Sched& S, const Epi& E) {
    int tid_ = threadIdx.x, K_ = g.K; asm volatile("" : "+v"(tid_), "+s"(K_));
    const int tid = tid_, wid = __builtin_amdgcn_readfirstlane(tid >> 6), lane = tid & 63, wr = wid >> 2, wc = wid & 3, fr = lane & 15, fq = lane >> 4;
    const int K = K_, nt = K / BK;
    unsigned voffA[2], voffB[2];
#pragma unroll
    for (int i = 0; i < 2; ++i) { int R, C; stage_rc(tid * 16 + i * 8192, R, C); const int Rb = Epi::PERM ? ((R & ~31) + perm32(R & 31)) : R;
        voffA[i] = (unsigned)(R * K + C) * 2u; voffB[i] = (unsigned)(Rb * K + C) * 2u; }
    const size_t kstep = (size_t)(BK * 2);
    const size_t hstep = (size_t)HALF * K * 2;
    const size_t tstep = 2 * hstep;
    const unsigned ldsw = (unsigned)wid * 1024u;
    const int aoff = lds_byte(wr * 64 + fr, fq * 8), boff = lds_byte(wc * 32 + fr, fq * 8);
#define PG8_SA(b, h) (((b) * 2 + (h)) * HTB)
#define PG8_SB(b, h) ((4 + (b) * 2 + (h)) * HTB)
#define PG8_STAGE(bufoff, gbase, voff) do { _Pragma("unroll") for (int _i = 0; _i < 2; ++_i) \
        __builtin_amdgcn_global_load_lds((const unsigned*)((const char*)(gbase) + (voff)[_i]), (PG8_LAS unsigned*)(lds + (bufoff) + ldsw + _i * 8192), 16, 0, 0); } while (0)
#define PG8_LDA(dst, b, h) do { _Pragma("unroll") for (int m = 0; m < 4; ++m) _Pragma("unroll") for (int k = 0; k < 2; ++k) dst[m][k] = *(const PG8_LAS bf16x8*)(lds + PG8_SA(b, h) + aoff + m * 2048 + k * 1024); } while (0)
#define PG8_LDB(dst, b, h) do { _Pragma("unroll") for (int n = 0; n < 2; ++n) _Pragma("unroll") for (int k = 0; k < 2; ++k) dst[n][k] = *(const PG8_LAS bf16x8*)(lds + PG8_SB(b, h) + boff + n * 2048 + k * 1024); } while (0)
#define PG8_MMA(ai, bj, At, Bt) do { __builtin_amdgcn_s_setprio(1); _Pragma("unroll") for (int m = 0; m < 4; ++m) _Pragma("unroll") for (int n = 0; n < 2; ++n) _Pragma("unroll") for (int k = 0; k < 2; ++k) \
        acc[ai][bj][m][n] = __builtin_amdgcn_mfma_f32_16x16x32_bf16(Bt[n][k], At[m][k], acc[ai][bj][m][n], 0, 0, 0); __builtin_amdgcn_s_setprio(0); } while (0)
#define PG8_WAIT_V(n) asm volatile("s_waitcnt vmcnt(" #n ")" ::: "memory")
#define PG8_WAIT_L(n) asm volatile("s_waitcnt lgkmcnt(" #n ")" ::: "memory")
#define PG8_BAR __builtin_amdgcn_s_barrier()
#define PG8_SCHED __builtin_amdgcn_sched_barrier(0)
    Unit cur, nxt; int ui = 0;
    if (!S.next(0, cur)) return;
    f32x4 acc[2][2][4][2];
#pragma unroll
    for (int a = 0; a < 2; ++a)
#pragma unroll
        for (int b = 0; b < 2; ++b)
#pragma unroll
            for (int m = 0; m < 4; ++m)
#pragma unroll
                for (int n = 0; n < 2; ++n) acc[a][b][m][n] = (f32x4){0.f, 0.f, 0.f, 0.f};
    bf16x8 At[4][2], B0[2][2], B1[2][2];
    const char* cA = (const char*)g.A + (size_t)cur.pm * tstep; const char* cB = (const char*)g.Bt + (size_t)cur.pn * tstep;
    S.a_ready(cur);
    if constexpr (SP2) {
        PG8_STAGE(PG8_SB(0, 0), cB, voffB); PG8_STAGE(PG8_SB(0, 1), cB + hstep, voffB); PG8_STAGE(PG8_SA(0, 0), cA, voffA); PG8_STAGE(PG8_SA(0, 1), cA + hstep, voffA);
        if (wr == 1) PG8_BAR;
        PG8_WAIT_V(2); PG8_BAR;
        PG8_STAGE(PG8_SB(1, 0), cB + kstep, voffB); PG8_STAGE(PG8_SA(1, 0), cA + kstep, voffA); PG8_STAGE(PG8_SB(1, 1), cB + hstep + kstep, voffB);
        PG8_WAIT_V(6); PG8_BAR;
    } else {
        PG8_STAGE(PG8_SB(0, 0), cB, voffB); PG8_STAGE(PG8_SA(0, 0), cA, voffA); PG8_STAGE(PG8_SB(0, 1), cB + hstep, voffB); PG8_STAGE(PG8_SA(0, 1), cA + hstep, voffA);
        if (wr == 1) PG8_BAR;
        PG8_WAIT_V(4); PG8_BAR;
        PG8_STAGE(PG8_SB(1, 0), cB + kstep, voffB); PG8_STAGE(PG8_SA(1, 0), cA + kstep, voffA); PG8_STAGE(PG8_SB(1, 1), cB + hstep + kstep, voffB);
        PG8_WAIT_V(6); PG8_BAR;
    }
    for (;;) {
        const bool has_next = S.next(ui + 1, nxt);
        const char* nA = has_next ? (const char*)g.A + (size_t)nxt.pm * tstep : cA; const char* nB = has_next ? (const char*)g.Bt + (size_t)nxt.pn * tstep : cB;
        for (int t = 0; t < nt; t += 2) {
            const bool last = (t == nt - 2);
            const char* a1 = cA + (size_t)(t + 1) * kstep;
            const char* a2 = last ? nA : cA + (size_t)(t + 2) * kstep; const char* b2 = last ? nB : cB + (size_t)(t + 2) * kstep;
            const char* a3 = a2 + kstep; const char* b3 = b2 + kstep;
            if (last && has_next) S.a_ready(nxt);
            if constexpr (SP2) {
            PG8_LDB(B0, 0, 0); PG8_LDB(B1, 0, 1); PG8_SCHED; PG8_LDA(At, 0, 0); PG8_STAGE(PG8_SA(1, 1), a1 + hstep, voffA);
            PG8_WAIT_V(8); PG8_WAIT_L(0); PG8_BAR; PG8_MMA(0, 0, At, B0); PG8_MMA(0, 1, At, B1); PG8_BAR; PG8_SCHED;
            PG8_LDA(At, 0, 1); PG8_STAGE(PG8_SB(0, 0), b2, voffB); PG8_STAGE(PG8_SB(0, 1), b2 + hstep, voffB); PG8_STAGE(PG8_SA(0, 0), a2, voffA);
            PG8_WAIT_V(8); PG8_WAIT_L(0); PG8_BAR; PG8_MMA(1, 0, At, B0); PG8_MMA(1, 1, At, B1); PG8_BAR; PG8_SCHED;
            PG8_LDB(B0, 1, 0); PG8_LDB(B1, 1, 1); PG8_SCHED; PG8_LDA(At, 1, 0); PG8_STAGE(PG8_SA(0, 1), a2 + hstep, voffA);
            PG8_WAIT_V(8); PG8_WAIT_L(0); PG8_BAR; PG8_MMA(0, 0, At, B0); PG8_MMA(0, 1, At, B1); PG8_BAR; PG8_SCHED;
            PG8_LDA(At, 1, 1); PG8_STAGE(PG8_SB(1, 0), b3, voffB); PG8_STAGE(PG8_SB(1, 1), b3 + hstep, voffB); PG8_STAGE(PG8_SA(1, 0), a3, voffA);
            PG8_WAIT_V(8); PG8_WAIT_L(0); PG8_BAR; PG8_MMA(1, 0, At, B0); PG8_MMA(1, 1, At, B1); PG8_BAR; PG8_SCHED;
            } else {
            PG8_LDB(B0, 0, 0); PG8_SCHED; PG8_LDA(At, 0, 0); PG8_STAGE(PG8_SA(1, 1), a1 + hstep, voffA);
            PG8_WAIT_L(8); PG8_BAR; PG8_WAIT_L(0); PG8_MMA(0, 0, At, B0); PG8_BAR; PG8_SCHED;
            PG8_LDB(B1, 0, 1); PG8_STAGE(PG8_SB(0, 0), b2, voffB);
            PG8_BAR; PG8_WAIT_L(0); PG8_MMA(0, 1, At, B1); PG8_BAR;
            PG8_LDA(At, 0, 1); PG8_STAGE(PG8_SA(0, 0), a2, voffA);
            PG8_BAR; PG8_WAIT_L(0); PG8_MMA(1, 0, At, B0); PG8_BAR; PG8_SCHED;
            PG8_STAGE(PG8_SB(0, 1), b2 + hstep, voffB);
            PG8_WAIT_V(6); PG8_BAR; PG8_MMA(1, 1, At, B1); PG8_BAR;
            PG8_LDB(B0, 1, 0); PG8_SCHED; PG8_LDA(At, 1, 0); PG8_STAGE(PG8_SA(0, 1), a2 + hstep, voffA);
            PG8_WAIT_L(8); PG8_BAR; PG8_WAIT_L(0); PG8_MMA(0, 0, At, B0); PG8_BAR; PG8_SCHED;
            PG8_LDB(B1, 1, 1); PG8_STAGE(PG8_SB(1, 0), b3, voffB);
            PG8_BAR; PG8_WAIT_L(0); PG8_MMA(0, 1, At, B1); PG8_BAR;
            PG8_LDA(At, 1, 1); PG8_STAGE(PG8_SA(1, 0), a3, voffA);
            PG8_BAR; PG8_WAIT_L(0); PG8_MMA(1, 0, At, B0); PG8_BAR; PG8_SCHED;
            PG8_STAGE(PG8_SB(1, 1), b3 + hstep, voffB);
            PG8_WAIT_V(6); PG8_BAR; PG8_MMA(1, 1, At, B1); PG8_BAR;
            }
        }
        if constexpr (ALIGN_EPI) { if (wr == 0) PG8_BAR; }
        if constexpr (!Epi::AFTER_DRAIN) { E(acc, cur, wr, wc, fr, fq); S.done(cur); }
        if (!has_next) break;
#pragma unroll
        for (int a = 0; a < 2; ++a)
#pragma unroll
            for (int b = 0; b < 2; ++b)
#pragma unroll
                for (int m = 0; m < 4; ++m)
#pragma unroll
                    for (int n = 0; n < 2; ++n) acc[a][b][m][n] = (f32x4){0.f, 0.f, 0.f, 0.f};
        cur = nxt; cA = nA; cB = nB; ++ui;
        if constexpr (ALIGN_EPI) { if (wr == 1) PG8_BAR; }
    }
    PG8_WAIT_V(0);
    if constexpr (!ALIGN_EPI) { if (wr == 0) PG8_BAR; }
    PG8_BAR;
    if constexpr (Epi::AFTER_DRAIN) { E.fused(acc, cur, wr, wc, fr, fq, lds, wid, lane); S.done(cur); }
#undef PG8_SA
#undef PG8_SB
#undef PG8_STAGE
#undef PG8_LDA
#undef PG8_LDB
#undef PG8_MMA
#undef PG8_WAIT_V
#undef PG8_WAIT_L
#undef PG8_BAR
#undef PG8_SCHED
}
}
namespace att {
typedef unsigned short bf16_t;
typedef short bf16x8 __attribute__((ext_vector_type(8)));
typedef short s16x4 __attribute__((ext_vector_type(4)));
typedef float f32x16 __attribute__((ext_vector_type(16)));
typedef unsigned u32x4 __attribute__((ext_vector_type(4)));
typedef unsigned u32x2 __attribute__((ext_vector_type(2)));
#define ATT_LAS __attribute__((address_space(3)))
struct UnitDesc {
    const bf16_t* qptr; bf16_t* optr;
    const bf16_t *kmeta, *vmeta, *kmain, *vmain;
    int t_lo, t_hi, tq; float sinkl2;
};
__device__ __forceinline__ int crow(int r, int hi) { return (r & 3) + 8 * (r >> 2) + 4 * hi; }
typedef float f32x2_t __attribute__((ext_vector_type(2))); typedef __bf16 bf16x2_t __attribute__((ext_vector_type(2)));
__device__ __forceinline__ unsigned cvtpk(float lo, float hi) { f32x2_t v = {lo, hi}; bf16x2_t b = __builtin_convertvector(v, bf16x2_t); return __builtin_bit_cast(unsigned, b); }
__device__ __forceinline__ float swapsum(float v) { auto rr = __builtin_amdgcn_permlane32_swap(__float_as_uint(v), __float_as_uint(v), false, false); return __uint_as_float(rr[0]) + __uint_as_float(rr[1]); }
__device__ __forceinline__ float swapmax(float v) { auto rr = __builtin_amdgcn_permlane32_swap(__float_as_uint(v), __float_as_uint(v), false, false); return fmaxf(__uint_as_float(rr[0]), __uint_as_float(rr[1])); }

template <int DQK, bool BAND>
__device__ __forceinline__ void attn_unit(ATT_LAS unsigned char* lds, const UnitDesc& d) {
    constexpr int KROW = DQK * 2 + 16, VROW = 144, KBUF = 64 * KROW, VBUF = 64 * VROW, KCH = DQK / 8, NKC = 64 * KCH, NDS = DQK / 16;
    int tid_ = threadIdx.x; asm volatile("" : "+v"(tid_));
    const int tid = tid_, lane = tid & 63, r32 = lane & 31, hi = lane >> 5;
    bf16x8 qr[NDS];
#pragma unroll
    for (int ds = 0; ds < NDS; ++ds) qr[ds] = *(const bf16x8*)(d.qptr + ds * 16 + hi * 8);
    f32x16 o0, o1;
#pragma unroll
    for (int r = 0; r < 16; ++r) { o0[r] = 0.f; o1[r] = 0.f; }
    float mrun = -INFINITY, lrun = 0.f;
    u32x4 sk0, sk1 = {0u, 0u, 0u, 0u}, sv;
    const int nt = 1 + (d.t_hi - d.t_lo);
#define ATT_GLOAD(tile) do { const int t_ = (tile); const bf16_t* kt_ = t_ < 0 ? d.kmeta : d.kmain + (size_t)t_ * 64 * DQK; \
        sk0 = *(const u32x4*)(kt_ + tid * 8); if (NKC > 512) { if (tid < NKC - 512) sk1 = *(const u32x4*)(kt_ + (tid + 512) * 8); } \
        const bf16_t* vt_ = t_ < 0 ? d.vmeta : d.vmain + t_ * 64; const int vp_ = t_ < 0 ? 64 : MH; \
        sv = *(const u32x4*)(vt_ + (size_t)(tid >> 3) * vp_ + (tid & 7) * 8); } while (0)
#define ATT_LSTORE(buf) do { const int b_ = (buf); *(ATT_LAS u32x4*)(lds + b_ * KBUF + (tid / KCH) * KROW + (tid % KCH) * 16) = sk0; \
        if (NKC > 512) { if (tid < NKC - 512) *(ATT_LAS u32x4*)(lds + b_ * KBUF + ((tid + 512) / KCH) * KROW + ((tid + 512) % KCH) * 16) = sk1; } \
        *(ATT_LAS u32x4*)(lds + 2 * KBUF + b_ * VBUF + (tid >> 3) * VROW + (tid & 7) * 16) = sv; } while (0)
    ATT_GLOAD(-1); ATT_LSTORE(0); __syncthreads();
    for (int it = 0; it < nt; ++it) {
        const int buf = it & 1, tile = it == 0 ? -1 : d.t_lo + it - 1; const bool more = it + 1 < nt;
        if (more) ATT_GLOAD(d.t_lo + it);
        const ATT_LAS unsigned char* kb = lds + buf * KBUF + r32 * KROW + hi * 16;
        f32x16 p0, p1;
#pragma unroll
        for (int r = 0; r < 16; ++r) { p0[r] = 0.f; p1[r] = 0.f; }
#pragma unroll
        for (int ds = 0; ds < NDS; ++ds) {
            const bf16x8 k0 = *(const ATT_LAS bf16x8*)(kb + ds * 32), k1 = *(const ATT_LAS bf16x8*)(kb + 32 * KROW + ds * 32);
            p0 = __builtin_amdgcn_mfma_f32_32x32x16_bf16(k0, qr[ds], p0, 0, 0, 0);
            p1 = __builtin_amdgcn_mfma_f32_32x32x16_bf16(k1, qr[ds], p1, 0, 0, 0);
        }
        if (tile < 0) {
#pragma unroll
            for (int r = 0; r < 16; ++r) { p0[r] = -INFINITY; if (r < 8) p1[r] = -INFINITY; }
        } else if (BAND) {
            const int dk = tile * 64 - d.tq;
#pragma unroll
            for (int r = 0; r < 16; ++r) { const int df = dk + crow(r, hi); if (df > 128 || df < -128) p0[r] = -INFINITY; if (df + 32 > 128 || df + 32 < -128) p1[r] = -INFINITY; }
        }
        float rm = fmaxf(p0[0], p1[0]);
#pragma unroll
        for (int r = 1; r < 16; ++r) rm = fmaxf(rm, fmaxf(p0[r], p1[r]));
        rm = swapmax(rm);
        const float mn = fmaxf(mrun, rm), alpha = __builtin_amdgcn_exp2f(mrun - mn); mrun = mn;
        float rsum = 0.f;
#pragma unroll
        for (int r = 0; r < 16; ++r) { p0[r] = __builtin_amdgcn_exp2f(p0[r] - mn); p1[r] = __builtin_amdgcn_exp2f(p1[r] - mn); rsum += p0[r] + p1[r]; }
        lrun = lrun * alpha + rsum;
#pragma unroll
        for (int r = 0; r < 16; ++r) { o0[r] *= alpha; o1[r] *= alpha; }
        u32x4 pw[4];
#pragma unroll
        for (int j = 0; j < 4; ++j) { pw[0][j] = cvtpk(p0[2 * j], p0[2 * j + 1]); pw[1][j] = cvtpk(p0[8 + 2 * j], p0[9 + 2 * j]); pw[2][j] = cvtpk(p1[2 * j], p1[2 * j + 1]); pw[3][j] = cvtpk(p1[8 + 2 * j], p1[9 + 2 * j]); }
        const ATT_LAS unsigned char* vb = lds + 2 * KBUF + buf * VBUF + r32 * VROW + hi * 8;
#pragma unroll
        for (int s = 0; s < 4; ++s) {
            const bf16x8 pb = __builtin_bit_cast(bf16x8, pw[s]);
            { const s16x4 lo = *(const ATT_LAS s16x4*)(vb + s * 32), h4 = *(const ATT_LAS s16x4*)(vb + s * 32 + 16);
              const bf16x8 vf = {lo[0], lo[1], lo[2], lo[3], h4[0], h4[1], h4[2], h4[3]}; o0 = __builtin_amdgcn_mfma_f32_32x32x16_bf16(vf, pb, o0, 0, 0, 0); }
            { const s16x4 lo = *(const ATT_LAS s16x4*)(vb + 32 * VROW + s * 32), h4 = *(const ATT_LAS s16x4*)(vb + 32 * VROW + s * 32 + 16);
              const bf16x8 vf = {lo[0], lo[1], lo[2], lo[3], h4[0], h4[1], h4[2], h4[3]}; o1 = __builtin_amdgcn_mfma_f32_32x32x16_bf16(vf, pb, o1, 0, 0, 0); }
        }
        if (more) ATT_LSTORE(buf ^ 1);
        __syncthreads();
    }
#undef ATT_GLOAD
#undef ATT_LSTORE
    float lt = swapsum(lrun);
    if (BAND) lt += __builtin_amdgcn_exp2f(d.sinkl2 - mrun);
    const float il = 1.0f / lt;
#pragma unroll
    for (int g = 0; g < 4; ++g) {
        u32x2 w0, w1;
        w0.x = cvtpk(o0[4 * g] * il, o0[4 * g + 1] * il); w0.y = cvtpk(o0[4 * g + 2] * il, o0[4 * g + 3] * il);
        w1.x = cvtpk(o1[4 * g] * il, o1[4 * g + 1] * il); w1.y = cvtpk(o1[4 * g + 2] * il, o1[4 * g + 3] * il);
        *(u32x2*)(d.optr + 8 * g + 4 * hi) = w0; *(u32x2*)(d.optr + 32 + 8 * g + 4 * hi) = w1;
    }
}
}

#define LAS __attribute__((address_space(3)))
typedef unsigned short bf16;
typedef float f32x4 __attribute__((ext_vector_type(4)));
typedef unsigned v4u __attribute__((ext_vector_type(4)));
typedef unsigned v2u __attribute__((ext_vector_type(2)));
__device__ __forceinline__ float wave_sum(float v) {
#pragma unroll
    for (int o = 1; o < 64; o <<= 1) v += __shfl_xor(v, o);
    return v;
}
__device__ __forceinline__ unsigned f2bf(float f) { unsigned u = __builtin_bit_cast(unsigned, f); return (u + 0x7fffu + ((u >> 16) & 1u)) >> 16; }
__device__ __forceinline__ unsigned pk2(float lo, float hi) { return f2bf(lo) | (f2bf(hi) << 16); }

template <class KM, class NM>
__device__ __forceinline__ void transpose_item(const float* W, int Nsrc, int Kdst, int Ndst, bf16* WT, const float* gain, LAS float* scr, int item, int lane, KM kmap, NM nmap) {
    const int nblk = Ndst / 32, kb = item / nblk, nb = item % nblk, k0 = 64 * kb, n0 = 32 * nb;
    const int sn = nmap(n0 + (lane & 31));
#pragma unroll 8
    for (int i = 0; i < 32; ++i) { const int kk = 2 * i + (lane >> 5), sk = kmap(k0 + kk);
        float v = 0.f; if (sk >= 0 && sn >= 0) { v = W[(size_t)sk * Nsrc + sn]; if (gain) v *= gain[sk]; }
        scr[kk * 33 + (lane & 31)] = v; }
    asm volatile("s_waitcnt lgkmcnt(0)" ::: "memory");
    const int c = lane & 7;
#pragma unroll
    for (int j = 0; j < 4; ++j) { const int n = (lane >> 3) + 8 * j; const LAS float* s = scr + (8 * c) * 33 + n;
        v4u o; o.x = pk2(s[0 * 33], s[1 * 33]); o.y = pk2(s[2 * 33], s[3 * 33]); o.z = pk2(s[4 * 33], s[5 * 33]); o.w = pk2(s[6 * 33], s[7 * 33]);
        *(v4u*)(WT + (size_t)(n0 + n) * Kdst + k0 + 8 * c) = o; }
    asm volatile("s_waitcnt lgkmcnt(0)" ::: "memory");
}
__device__ __forceinline__ int nmap_win(int n) {
    if (n < 384) return n;
    if (n < 512) { const int j = n - 384, g = j >> 6, c = j & 63, i = c >> 1; return 1184 + g * 64 + ((c & 1) ? i + 32 : i); }
    if (n < 768) return 384 + (n - 512);
    if (n < 1280) { const int j = n - 768, h = j >> 6, c = j & 63, i = c >> 1; return 672 + h * 64 + ((c & 1) ? i + 32 : i); }
    if (n < 1408) return 1312 + (n - 1280);
    if (n < 1440) { const int j = n - 1408, i = j >> 1; return 640 + ((j & 1) ? i + 16 : i); }
    if (n < 1536) return -1;
    if (n < 2560) return 1440 + (n - 1536);
    return 2464 + (n - 2560);
}

__device__ __forceinline__ void row_one(int lane, const float* Frow, const float* brow, const float* gain, float coef, float* orow, bf16* xrow, float* xrow_f32) {
    f32x4 b[4];
#pragma unroll
    for (int j = 0; j < 4; ++j) b[j] = *((const f32x4*)brow + lane + 64 * j);
    if (Frow) {
        f32x4 f[4]; float s = 0.f;
#pragma unroll
        for (int j = 0; j < 4; ++j) { f[j] = *((const f32x4*)Frow + lane + 64 * j); s += (f[j][0] * f[j][0] + f[j][1] * f[j][1]) + (f[j][2] * f[j][2] + f[j][3] * f[j][3]); }
        const float r = rsqrtf(wave_sum(s) * (1.f / DM) + RMS_EPS) * coef;
#pragma unroll
        for (int j = 0; j < 4; ++j) { const f32x4 g = *((const f32x4*)gain + lane + 64 * j); b[j] += f[j] * r * g; }
    }
    if (orow) {
#pragma unroll
        for (int j = 0; j < 4; ++j) *((f32x4*)orow + lane + 64 * j) = b[j];
    }
    if (xrow || xrow_f32) {
        float s = 0.f;
#pragma unroll
        for (int j = 0; j < 4; ++j) s += (b[j][0] * b[j][0] + b[j][1] * b[j][1]) + (b[j][2] * b[j][2] + b[j][3] * b[j][3]);
        const float r = rsqrtf(wave_sum(s) * (1.f / DM) + RMS_EPS);
        if (xrow) {
#pragma unroll
            for (int j = 0; j < 4; ++j) { v2u w; w.x = pk2(b[j][0] * r, b[j][1] * r); w.y = pk2(b[j][2] * r, b[j][3] * r); *((v2u*)xrow + lane + 64 * j) = w; }
        }
        if (xrow_f32) {
#pragma unroll
            for (int j = 0; j < 4; ++j) *((f32x4*)xrow_f32 + lane + 64 * j) = b[j] * r;
        }
    }
}
__device__ __forceinline__ void rowpass(int gw, int ngw, int lane, const float* F, const float* base, const float* gain, float coef, float* out, bf16* xn) {
    for (int m = gw; m < MH; m += ngw)
        row_one(lane, F ? F + (size_t)m * DM : nullptr, base + (size_t)m * DM, gain, coef, out ? out + (size_t)m * DM : nullptr, xn ? xn + (size_t)m * DM : nullptr, nullptr);
}

template <class CM, class AF, class OF>
__device__ __forceinline__ void skinny(const bf16* Bt, int K, int ncols, int gw, int ngw, int lane, CM cmap, AF af, OF of) {
    for (int c = gw; c < ncols; c += ngw) {
        const int n = cmap(c);
        float acc[16];
#pragma unroll
        for (int r = 0; r < 16; ++r) acc[r] = 0.f;
        for (int k = lane; k < K; k += 64) {
            const float b = bf2f(Bt[(size_t)n * K + k]);
#pragma unroll
            for (int r = 0; r < 16; ++r) acc[r] += af(r, k) * b;
        }
#pragma unroll
        for (int r = 0; r < 16; ++r) acc[r] = wave_sum(acc[r]);
        if (lane == 0) {
#pragma unroll
            for (int r = 0; r < 16; ++r) of(r, n, acc[r]);
        }
    }
}

#ifndef DUMP_OFF
#define DUMP_OFF 0
#define DUMP_CNT 0
#endif
#ifndef PH_LIMIT
#define PH_LIMIT 1000
#endif

#ifndef PH_MASK
#define PH_MASK 0xFFFFFFu
#endif
struct Args { const float* in[22]; float* out; unsigned char* ws; int ph_lo, ph_hi; };
typedef const __attribute__((address_space(4))) unsigned char* kargp_t;
__device__ __forceinline__ kargp_t kargp() { kargp_t k = (kargp_t)__builtin_amdgcn_kernarg_segment_ptr(); asm volatile("" : "+s"(k)); return k; }
#define KIN(i) (*(const float* const __attribute__((address_space(4)))*)(kargp() + 8 * (i)))
#define KOUT() (*(float* const __attribute__((address_space(4)))*)(kargp() + 8 * 22))
#define KWS() (*(unsigned char* const __attribute__((address_space(4)))*)(kargp() + 8 * 23))
#define WSP(T, off) ((T*)(KWS() + (off)))

enum { C_P0 = 0, C_M1, C_P1, C_M2, C_P2, C_R2, C_M4, C_P3, C_M5, C_P4A, C_P4B, C_P5, C_P6A, C_P6B, C_P7, C_R7, C_P8, C_P9, C_R9, C_FILL, C_NUM };
constexpr int N_PHASES = 1 + 18 + 14;
__device__ __forceinline__ void prog(int ph, int& code, int& half, bool& nosync) {
    if (ph == 0) { code = C_P0; half = 0; nosync = false; return; }
    if (ph >= 200) { code = C_FILL + 1; half = 0; nosync = false; return; }
    if (ph >= 100) { code = C_FILL; half = ph - 100; nosync = false; return; }
    if (ph <= 18) { code = ph; half = 0; }
    else { const int q = ph - 19; half = 1; code = q == 0 ? C_P1 : q == 1 ? C_P2 : q == 2 ? C_R2 : q == 3 ? C_P3 : C_P4A + (q - 4); }
    nosync = (code == C_M1 || code == C_M2 || code == C_M4 || code == C_M5 || code == C_P4A || code == C_P6A);
}

__global__ void __launch_bounds__(NWAVES * 64, 2) enc_fwd(Args args) {
    extern __shared__ __attribute__((aligned(16))) unsigned char lds_raw[];
    cg::grid_group grid = cg::this_grid();
    LAS unsigned char* lds = (LAS unsigned char*)lds_raw;
    const int ph_hi = args.ph_hi;

    for (int ph = args.ph_lo; ph < ph_hi; ++ph) {
        int code, half; bool nosync; prog(ph, code, half, nosync);
#define IDS() int tid_ = threadIdx.x, G_ = gridDim.x, bx_ = blockIdx.x; asm volatile("" : "+v"(tid_), "+s"(G_), "+s"(bx_)); \
        const int tid = tid_, lane = tid & 63, wave = __builtin_amdgcn_readfirstlane(tid >> 6); \
        const int G = G_, bx = bx_, vcu = (G % 8 == 0) ? (bx % 8) * (G / 8) + bx / 8 : bx; \
        const int gw = vcu * NWAVES + wave, ngw = G * NWAVES; (void)tid; (void)lane; (void)gw; (void)ngw; (void)vcu
#define GIDS() int G_ = gridDim.x, bx_ = blockIdx.x; asm volatile("" : "+s"(G_), "+s"(bx_))
        const int S = half ? 8192 : 2048, logS = half ? 13 : 11, smask = S - 1, rofs = half * MH;
        switch (((PH_MASK >> code) & 1u) ? code : 99) {
        case C_P0: { IDS();
            LAS float* scr = (LAS float*)(lds + wave * 16384);
            auto idk = [](int k) { return k; }; auto idn = [](int n) { return n; };
            auto nm_w1 = [](int n) { const int t = n >> 8, w = n & 255; return w < 128 ? t * 128 + w : DFF + t * 128 + (w - 128); };
            auto nm_uq = [](int n) { const int h = n / 96, c = n % 96; if (c < 64) return h * 96 + c; const int j = c - 64, i = j >> 1; return h * 96 + 64 + ((j & 1) ? i + 16 : i); };
            auto nm_ukv = [](int n) { const int m = n & 511, h = m >> 6, d = m & 63; return h * 128 + (n < 512 ? 0 : 64) + d; };
            auto km_oa = [](int k) { const int h = k / 96, d = k % 96; return d < 64 ? h * 64 + d : -1; };
            constexpr int I1 = 16 * 176, I2 = 44 * 32, I3 = 16 * 112, I4 = 6 * 24, I5 = 4 * 32, I6 = 12 * 32, I7 = 8 * 32, I8 = 16 * 32;
            constexpr int NIT = 2 * I1 + 2 * I2 + I3 + I4 + I5 + I6 + I7 + I8;
            for (int it = gw; it < NIT; it += ngw) {
                int r = it;
                if (r < I1) { transpose_item(KIN(4), 2 * DFF, DM, 2 * DFF, WSP(bf16, WS_W1T), KIN(3), scr, r, lane, idk, nm_w1); continue; } r -= I1;
                if (r < I1) { transpose_item(KIN(19), 2 * DFF, DM, 2 * DFF, WSP(bf16, WS_W1T2), KIN(18), scr, r, lane, idk, nm_w1); continue; } r -= I1;
                if (r < I2) { transpose_item(KIN(5), DM, DFF, DM, WSP(bf16, WS_W2T), nullptr, scr, r, lane, idk, idn); continue; } r -= I2;
                if (r < I2) { transpose_item(KIN(20), DM, DFF, DM, WSP(bf16, WS_W2T2), nullptr, scr, r, lane, idk, idn); continue; } r -= I2;
                if (r < I3) { transpose_item(KIN(8), 3488, DM, N_WIN, WSP(bf16, WS_WINT), KIN(7), scr, r, lane, idk, [](int n) { return nmap_win(n); }); continue; } r -= I3;
                if (r < I4) { transpose_item(KIN(10), 768, 384, 768, WSP(bf16, WS_WUQT), KIN(9), scr, r, lane, idk, nm_uq); continue; } r -= I4;
                if (r < I5) { transpose_item(KIN(12), 1024, 256, 1024, WSP(bf16, WS_WUKVT), KIN(11), scr, r, lane, idk, nm_ukv); continue; } r -= I5;
                if (r < I6) { transpose_item(KIN(14), 1024, 768, 1024, WSP(bf16, WS_WOAT), nullptr, scr, r, lane, km_oa, idn); continue; } r -= I6;
                if (r < I7) { transpose_item(KIN(15), 1024, 512, 1024, WSP(bf16, WS_WOBT), nullptr, scr, r, lane, idk, idn); continue; } r -= I7;
                transpose_item(KIN(16), 1024, 1024, 1024, WSP(bf16, WS_WOUTT), nullptr, scr, r, lane, idk, idn);
            }
            { float* z = WSP(float, WS_SSQQ); for (int i = bx * 512 + tid; i < 2 * 32768; i += G * 512) z[i] = 0.f; }
            { unsigned* z = WSP(unsigned, WS_KMETA); for (int i = bx * 512 + tid; i < (int)((WS_RAWKV - WS_KMETA) / 4); i += G * 512) z[i] = 0u; }
            rowpass(gw, ngw, lane, nullptr, KIN(0), nullptr, 0.f, nullptr, WSP(bf16, WS_XN));
            if (gw < 16) row_one(lane, nullptr, KIN(2) + (size_t)gw * DM, nullptr, 0.f, nullptr, nullptr, WSP(float, WS_XNM) + (size_t)gw * DM);
        } break;
        case C_M1: { IDS();
            const float* XNM = WSP(float, WS_XNM); float* RAW1 = WSP(float, WS_RAW1);
            skinny(WSP(bf16, WS_W1T), DM, 2 * DFF, gw, ngw, lane, [](int c) { return c; }, [=](int r, int k) { return XNM[r * DM + k]; }, [=](int r, int n, float v) { RAW1[r * (2 * DFF) + n] = v; });
        } break;
        case C_P1: { GIDS();
            pg8::Gemm g{WSP(bf16, WS_XN), WSP(bf16, WS_W1T), MH, 2 * DFF, DM}; pg8::StaticOrder So; So.init(MH, 2 * DFF, G_, bx_); pg8::EpiSwiglu E{KWS()};
            pg8::gemm_phase<pg8::EpiSwiglu, pg8::StaticOrder, true, true>(lds, g, So, E);
        } break;
        case C_M2: { IDS();
            const float* RAW1 = WSP(float, WS_RAW1); float* FM = WSP(float, WS_FM);
            skinny(WSP(bf16, WS_W2T), DFF, DM, gw, ngw, lane, [](int c) { return c; },
                [=](int r, int k) { const int t = k >> 7, w = k & 127; const float gg = RAW1[r * (2 * DFF) + t * 256 + w], uu = RAW1[r * (2 * DFF) + t * 256 + 128 + w]; return gg * sigm_f(gg) * uu; },
                [=](int r, int n, float v) { FM[r * DM + n] = v; });
        } break;
        case C_P2: { GIDS();
            pg8::Gemm g{WSP(bf16, R_ACT), WSP(bf16, WS_W2T), MH, DM, DFF}; pg8::StaticOrder So; So.init(MH, DM, G_, bx_); pg8::EpiF32 E{KOUT() + (size_t)rofs * DM, DM};
            pg8::gemm_phase<pg8::EpiF32, pg8::StaticOrder, true, true>(lds, g, So, E);
        } break;
        case C_R2: { IDS();
            float* xres = KOUT() + (size_t)rofs * DM;
            rowpass(gw, ngw, lane, xres, KIN(half), KIN(6), 0.5f, xres, WSP(bf16, WS_XN));
            if (half == 0 && gw < 16) row_one(lane, WSP(float, WS_FM) + (size_t)gw * DM, KIN(2) + (size_t)gw * DM, KIN(6), 0.5f, nullptr, nullptr, WSP(float, WS_H2M) + (size_t)gw * DM);
        } break;
        case C_M4: { IDS();
            const float* H2M = WSP(float, WS_H2M); float* RAWP = WSP(float, WS_RAWP);
            skinny(WSP(bf16, WS_WINT), DM, 544, gw, ngw, lane, [](int c) { return c < 128 ? 384 + c : (c < 384 ? 512 + (c - 128) : (c < 512 ? 1280 + (c - 384) : 1408 + (c - 512))); },
                [=](int r, int k) { return H2M[r * DM + k]; }, [=](int r, int n, float v) { RAWP[r * N_WIN + n] = v; });
        } break;
        case C_P3: { GIDS();
            pg8::Gemm g{WSP(bf16, WS_XN), WSP(bf16, WS_WINT), MH, N_WIN, DM}; pg8::StaticOrder So; So.init(MH, N_WIN, G_, bx_);
            pg8::EpiProj E{KWS(), rofs, smask};
            pg8::gemm_phase<pg8::EpiProj, pg8::StaticOrder, true, true>(lds, g, So, E);
        } break;
        case C_M5: { IDS();
            const float* RAWP = WSP(float, WS_RAWP);
            bf16* KMETA = WSP(bf16, WS_KMETA); bf16* VMETA = WSP(bf16, WS_VMETA);
            if (gw < 1024) {
                const bf16* WUKVT = WSP(bf16, WS_WUKVT);
                const int n = gw; float acc[16], ssr[16];
#pragma unroll
                for (int r = 0; r < 16; ++r) { acc[r] = 0.f; ssr[r] = 0.f; }
                for (int k = lane; k < 256; k += 64) { const float b = bf2f(WUKVT[(size_t)n * 256 + k]);
#pragma unroll
                    for (int r = 0; r < 16; ++r) { const float v = RAWP[r * N_WIN + 512 + k]; acc[r] += v * b; ssr[r] += v * v; } }
#pragma unroll
                for (int r = 0; r < 16; ++r) acc[r] = wave_sum(acc[r]) * rsqrtf(wave_sum(ssr[r]) * (1.f / 256.f) + RMS_EPS);
                if (lane == 0) { const int m = n & 511, h = m >> 6, d = m & 63;
#pragma unroll
                    for (int r = 0; r < 16; ++r) { if (n < 512) KMETA[(h * 64 + 48 + r) * 96 + d] = (bf16)f2bf(acc[r]); else VMETA[(h * 64 + d) * 64 + 48 + r] = (bf16)f2bf(acc[r]); } }
            }
            if (bx == 0) {
                bf16* KSMETA = WSP(bf16, WS_KSMETA); bf16* VSMETA = WSP(bf16, WS_VSMETA);
                for (int i = tid; i < 16 * 16; i += 512) {
                    const int r = i >> 4, p = i & 15; float c, s; rope_cs(r, __builtin_amdgcn_exp2f(-(float)p * (ROPE_L2T / 16.f)), c, s);
                    const float x1 = RAWP[r * N_WIN + 1408 + 2 * p], x2 = RAWP[r * N_WIN + 1408 + 2 * p + 1]; const bf16 o1 = (bf16)f2bf(x1 * c - x2 * s), o2 = (bf16)f2bf(x2 * c + x1 * s);
                    for (int h = 0; h < 8; ++h) { KMETA[(h * 64 + 48 + r) * 96 + 64 + 2 * p] = o1; KMETA[(h * 64 + 48 + r) * 96 + 64 + 2 * p + 1] = o2; } }
                for (int i = tid; i < 16 * 64; i += 512) {
                    const int r = i >> 6, gp = i & 63, g2 = gp >> 5, p = gp & 31; float c, s; rope_cs(r, __builtin_amdgcn_exp2f(-(float)p * (ROPE_L2T / 32.f)), c, s);
                    const float x1 = RAWP[r * N_WIN + 384 + g2 * 64 + 2 * p], x2 = RAWP[r * N_WIN + 384 + g2 * 64 + 2 * p + 1];
                    KSMETA[(g2 * 64 + 48 + r) * 64 + 2 * p] = (bf16)f2bf(x1 * c - x2 * s); KSMETA[(g2 * 64 + 48 + r) * 64 + 2 * p + 1] = (bf16)f2bf(x2 * c + x1 * s); }
                for (int i = tid; i < 16 * 128; i += 512) { const int r = i >> 7, gd = i & 127; VSMETA[gd * 64 + 48 + r] = (bf16)f2bf(RAWP[r * N_WIN + 1280 + gd]); }
            }
        } break;
        case C_P4A: { GIDS();
            pg8::Gemm g{WSP(bf16, R_CQ), WSP(bf16, WS_WUQT), MH, 768, 384}; pg8::StaticOrder So; So.init(MH, 768, G_, bx_); pg8::EpiQ E{KWS(), rofs, smask};
            pg8::gemm_phase<pg8::EpiQ, pg8::StaticOrder, true, true>(lds, g, So, E);
        } break;
        case C_P4B: { GIDS();
            pg8::Gemm g{WSP(bf16, R_CKV), WSP(bf16, WS_WUKVT), MH, 1024, 256}; pg8::StaticOrder So; So.init(MH, 1024, G_, bx_); pg8::EpiKV E{KWS(), rofs};
            pg8::gemm_phase<pg8::EpiKV, pg8::StaticOrder, true, true>(lds, g, So, E);
        } break;
        case C_P5: { IDS();
            for (int L = vcu; L < 512; L += G) {
                const int round = L >> 8, v = L & 255; int pair, qblk;
                if (half == 0) { pair = 8 * (v >> 5) + 4 * round + ((v & 31) >> 3); qblk = v & 7; } else { pair = 2 * (v >> 5) + round; qblk = v & 31; }
                const int seq = pair >> 3, h = pair & 7, row = seq * S + qblk * 256 + wave * 32 + (lane & 31);
                bf16* QA = WSP(bf16, R_QA);
                att::UnitDesc d; d.qptr = QA + (size_t)row * 768 + h * 96; d.optr = QA + (size_t)row * 768 + h * 96;
                d.kmeta = WSP(bf16, WS_KMETA) + h * 64 * 96; d.vmeta = WSP(bf16, WS_VMETA) + h * 64 * 64; d.kmain = WSP(bf16, R_KF) + ((size_t)h * MH + (size_t)seq * S) * 96; d.vmain = WSP(bf16, R_VT) + (size_t)h * 64 * MH + (size_t)seq * S;
                d.t_lo = 0; d.t_hi = S / 64; d.tq = 0; d.sinkl2 = 0.f;
                att::attn_unit<96, false>(lds, d);
            }
            for (int L = vcu; L < 512; L += G) {
                const int g2 = L >> 8, tt = L & 255, hrow0 = tt * 64, seq = hrow0 >> logS, t0 = hrow0 & smask;
                const int hq = g2 * 4 + (wave >> 1), qi = (wave & 1) * 32 + (lane & 31), row = hrow0 + qi;
                bf16* QS = WSP(bf16, R_QS);
                att::UnitDesc d; d.qptr = QS + (size_t)row * 512 + hq * 64; d.optr = QS + (size_t)row * 512 + hq * 64;
                d.kmeta = WSP(bf16, WS_KSMETA) + g2 * 64 * 64; d.vmeta = WSP(bf16, WS_VSMETA) + g2 * 64 * 64; d.kmain = WSP(bf16, R_KS) + ((size_t)g2 * MH + (size_t)seq * S) * 64; d.vmain = WSP(bf16, R_VTS) + (size_t)g2 * 64 * MH + (size_t)seq * S;
                const int tb = t0 >> 6; d.t_lo = tb - 2 < 0 ? 0 : tb - 2; d.t_hi = tb + 3 > S / 64 ? S / 64 : tb + 3; d.tq = t0 + qi; d.sinkl2 = KIN(13)[hq] * LOG2E_F;
                att::attn_unit<64, true>(lds, d);
            }
        } break;
        case C_P6A: { GIDS();
            pg8::Gemm g{WSP(bf16, R_QA), WSP(bf16, WS_WOAT), MH, DM, 768}; pg8::StaticOrder So; So.init(MH, DM, G_, bx_); pg8::EpiGate<false> E{KWS()};
            pg8::gemm_phase<pg8::EpiGate<false>, pg8::StaticOrder, true, true>(lds, g, So, E);
        } break;
        case C_P6B: { GIDS();
            pg8::Gemm g{WSP(bf16, R_QS), WSP(bf16, WS_WOBT), MH, DM, 512}; pg8::StaticOrder So; So.init(MH, DM, G_, bx_); pg8::EpiGate<true> E{KWS()};
            pg8::gemm_phase<pg8::EpiGate<true>, pg8::StaticOrder, true, true>(lds, g, So, E);
        } break;
        case C_P7: { GIDS();
            pg8::Gemm g{WSP(bf16, WS_XN), WSP(bf16, WS_WOUTT), MH, DM, DM}; pg8::StaticOrder So; So.init(MH, DM, G_, bx_); pg8::EpiF32 E{WSP(float, R_Y), DM};
            pg8::gemm_phase<pg8::EpiF32, pg8::StaticOrder, true, true>(lds, g, So, E);
        } break;
        case C_R7: { IDS(); float* xres = KOUT() + (size_t)rofs * DM; rowpass(gw, ngw, lane, WSP(float, R_Y), xres, KIN(17), 1.0f, xres, WSP(bf16, WS_XN)); } break;
        case C_P8: { GIDS();
            pg8::Gemm g{WSP(bf16, WS_XN), WSP(bf16, WS_W1T2), MH, 2 * DFF, DM}; pg8::StaticOrder So; So.init(MH, 2 * DFF, G_, bx_); pg8::EpiSwiglu E{KWS()};
            pg8::gemm_phase<pg8::EpiSwiglu, pg8::StaticOrder, true, true>(lds, g, So, E);
        } break;
        case C_P9: { GIDS();
            pg8::Gemm g{WSP(bf16, R_ACT), WSP(bf16, WS_W2T2), MH, DM, DFF}; pg8::StaticOrder So; So.init(MH, DM, G_, bx_); pg8::EpiF32 E{WSP(float, R_F2), DM};
            pg8::gemm_phase<pg8::EpiF32, pg8::StaticOrder, true, true>(lds, g, So, E);
        } break;
        case C_R9: { IDS();
            float* xres = KOUT() + (size_t)rofs * DM;
            rowpass(gw, ngw, lane, WSP(float, R_F2), xres, KIN(21), 0.5f, xres, nullptr);
            if (half == 0) rowpass(gw, ngw, lane, nullptr, KIN(1), nullptr, 0.f, nullptr, WSP(bf16, WS_XN));
        } break;
        case C_FILL: { IDS(); rowpass(gw, ngw, lane, nullptr, KIN(half), nullptr, 0.f, KOUT() + (size_t)rofs * DM, nullptr); } break;
        case C_FILL + 1: { IDS();
            const bf16* src = WSP(bf16, (size_t)DUMP_OFF); float* o = KOUT();
            for (size_t i = (size_t)bx * 512 + tid; i < (size_t)2 * MH * DM; i += (size_t)G * 512) o[i] = i < (size_t)DUMP_CNT ? bf2f(src[i]) : 0.f;
        } break;
        default: break;
        }
        if (ph + 1 < ph_hi) { if (nosync) { asm volatile("s_waitcnt vmcnt(0) lgkmcnt(0)" ::: "memory"); __syncthreads(); } else grid.sync(); }
    }
}

#ifndef MK_PER_PHASE
#define MK_PER_PHASE 0
#endif
extern "C" void kernel_launch(void* const* d_in, const int* in_sizes, int n_in, void* d_out, int out_size, void* d_ws, size_t ws_size, hipStream_t stream) {
    static int grid = 0;
    if (grid == 0) {
        if (n_in != 22 || ws_size < WS_END) { fprintf(stderr, "kernel_launch: unexpected problem (n_in %d, ws %zu)\n", n_in, ws_size); grid = -1; return; }
        int dev = 0, cus = 0, per_cu = 0;
        (void)hipGetDevice(&dev); (void)hipDeviceGetAttribute(&cus, hipDeviceAttributeMultiprocessorCount, dev);
        if (hipFuncSetAttribute((const void*)enc_fwd, hipFuncAttributeMaxDynamicSharedMemorySize, LDS_BYTES) != hipSuccess) { fprintf(stderr, "kernel_launch: hipFuncSetAttribute failed\n"); grid = -1; return; }
        if (hipOccupancyMaxActiveBlocksPerMultiprocessor(&per_cu, (const void*)enc_fwd, NWAVES * 64, LDS_BYTES) != hipSuccess || per_cu < 1) { fprintf(stderr, "kernel_launch: occupancy query failed (%d)\n", per_cu); (void)hipGetLastError(); per_cu = 1; }
        grid = cus;
    }
    if (grid < 0) return;
    Args a{};
    for (int i = 0; i < 22; ++i) a.in[i] = (const float*)d_in[i];
    a.out = (float*)d_out; a.ws = (unsigned char*)d_ws;
#if MK_PER_PHASE
    for (int p = 0; p < (PH_LIMIT < N_PHASES ? PH_LIMIT : N_PHASES); ++p) { a.ph_lo = p; a.ph_hi = p + 1; hipLaunchKernelGGL(enc_fwd, dim3(grid), dim3(NWAVES * 64), LDS_BYTES, stream, a); }
    if (DUMP_CNT > 0) { a.ph_lo = 200; a.ph_hi = 201; hipLaunchKernelGGL(enc_fwd, dim3(grid), dim3(NWAVES * 64), LDS_BYTES, stream, a); return; }
    if (PH_LIMIT < 6) { a.ph_lo = 100; a.ph_hi = 101; hipLaunchKernelGGL(enc_fwd, dim3(grid), dim3(NWAVES * 64), LDS_BYTES, stream, a); }
    if (PH_LIMIT < 22) { a.ph_lo = 101; a.ph_hi = 102; hipLaunchKernelGGL(enc_fwd, dim3(grid), dim3(NWAVES * 64), LDS_BYTES, stream, a); }
#else
    a.ph_lo = 0; a.ph_hi = N_PHASES;
    void* kargs[] = {&a};
    hipError_t e = hipLaunchCooperativeKernel((const void*)enc_fwd, dim3(grid), dim3(NWAVES * 64), kargs, LDS_BYTES, stream);
    if (e != hipSuccess) fprintf(stderr, "kernel_launch: cooperative launch failed: %s (grid %d)\n", hipGetErrorString(e), grid);
#endif
}
```
